# Optimizing an MI355X kernel written in HIP

```python
import jax, jax.numpy as jnp
from jax import lax
import numpy as np

D_MODEL = 1024
BATCH = 2
SEQ = 8192
DEPTH = 1

D_INNER = 2 * D_MODEL
SSD_HEAD_DIM = 64
SSD_HEADS = D_INNER // SSD_HEAD_DIM
SSD_GROUPS = 4
SSD_HEADS_PER_GROUP = SSD_HEADS // SSD_GROUPS
SSD_STATE = 128
CONV_WIDTH = 4
CHUNK = 128
XBC_WIDTH = D_INNER + 2 * SSD_GROUPS * SSD_STATE
DT_MIN = 0.001
DT_MAX = 0.1
POOL_WINDOWS = (2, 4, 8, 16)
POOL_GROUPS = len(POOL_WINDOWS)
POOL_WIDTH = D_MODEL
POOL_GROUP_WIDTH = POOL_WIDTH // POOL_GROUPS
N_BRANCHES = 2
D_FF = 4 * D_MODEL
N_MOD = 6
NORM_EPS = 1e-5
IN_SPLITS = (D_INNER,
             D_INNER + XBC_WIDTH,
             D_INNER + XBC_WIDTH + SSD_HEADS,
             D_INNER + XBC_WIDTH + SSD_HEADS + POOL_WIDTH)
IN_COLS = IN_SPLITS[-1] + N_BRANCHES * D_MODEL

kernel_name = "hybrid_ssd_pool_gated_block"


def rmsnorm(x, w, eps=NORM_EPS):
    x32 = x.astype(jnp.float32)
    y = x32 * lax.rsqrt(jnp.mean(x32 * x32, axis=-1, keepdims=True) + eps)
    return y.astype(x.dtype) * w


def causal_depthwise_conv(u, w, b):
    k_width = w.shape[0]
    seq = u.shape[1]
    up = jnp.pad(u, ((0, 0), (k_width - 1, 0), (0, 0)))
    out = b
    for k in range(k_width):
        out = out + up[:, k:k + seq] * w[k]
    return out


def segsum_decay(a_cs):
    q = a_cs.shape[-1]
    seg = a_cs[..., :, None] - a_cs[..., None, :]
    mask = jnp.tril(jnp.ones((q, q), dtype=bool))
    return jnp.exp(jnp.where(mask, seg, -jnp.inf))


def ssd_chunked_scan(xdt, dtA, bmat, cmat):
    b, seq, _, p = xdt.shape
    g, hg, n, q = SSD_GROUPS, SSD_HEADS_PER_GROUP, SSD_STATE, CHUNK
    nc = seq // q
    x = xdt.astype(jnp.float32).reshape(b, nc, q, g, hg, p)
    a = dtA.astype(jnp.float32).reshape(b, nc, q, g, hg).transpose(0, 3, 4, 1, 2)
    bc = bmat.astype(jnp.float32).reshape(b, nc, q, g, n)
    cc = cmat.astype(jnp.float32).reshape(b, nc, q, g, n)
    a_cs = jnp.cumsum(a, axis=-1)
    scores = jnp.einsum('bclgn,bcsgn->bgcls', cc, bc)
    mmat = scores[:, :, None] * segsum_decay(a_cs)
    y_diag = jnp.einsum('bghcls,bcsghp->bclghp', mmat, x)
    decay_states = jnp.exp(a_cs[..., -1:] - a_cs)
    states = jnp.einsum('bcsgn,bghcs,bcsghp->bcghpn', bc, decay_states, x)
    chunk_decay = jnp.exp(a_cs[..., -1])

    def step(h, inp):
        s_c, d_c = inp
        return h * d_c[..., None, None] + s_c, h

    h0 = jnp.zeros((b, g, hg, p, n), jnp.float32)
    _, prev = lax.scan(step, h0, (jnp.moveaxis(states, 1, 0), jnp.moveaxis(chunk_decay, 3, 0)))
    prev = jnp.moveaxis(prev, 0, 1)
    y_off = jnp.einsum('bclgn,bcghpn,bghcl->bclghp', cc, prev, jnp.exp(a_cs))
    return (y_diag + y_off).reshape(b, seq, SSD_HEADS, p)


def causal_multiscale_pool(u, pool_w, pool_scale):
    b, seq, _ = u.shape
    gw = POOL_GROUP_WIDTH
    u32 = u.astype(jnp.float32)
    cs = jnp.concatenate([jnp.zeros((b, 1, POOL_WIDTH), jnp.float32), jnp.cumsum(u32, axis=1)], axis=1)
    count = jnp.arange(1, seq + 1, dtype=jnp.float32)[:, None]
    outs = []
    for gi, win in enumerate(POOL_WINDOWS):
        csg = cs[:, :, gi * gw:(gi + 1) * gw]
        start = jnp.concatenate([jnp.zeros((b, win - 1, gw), jnp.float32), csg[:, :seq - win + 1]], axis=1)
        mean = (csg[:, 1:] - start) / jnp.minimum(count, float(win))
        outs.append(mean - u32[..., gi * gw:(gi + 1) * gw])
    pooled = jnp.stack(outs, axis=2).astype(u.dtype)
    y = jnp.einsum('blgc,gcd->blgd', pooled, pool_w).reshape(b, seq, POOL_WIDTH)
    return y * pool_scale


def hybrid_mixer(h, w_in, conv_w, conv_b, dt_bias, a_log, d_skip, ssd_norm_w,
                 w_branch_ssd, pool_w, pool_scale, w_branch_pool, w_out):
    b, seq, _ = h.shape
    proj = h @ w_in
    z, xbc, dt_raw, u_pool, gate_logits = jnp.split(proj, IN_SPLITS, axis=-1)
    xbc = jax.nn.silu(causal_depthwise_conv(xbc, conv_w, conv_b))
    xs, bmat, cmat = jnp.split(xbc, (D_INNER, D_INNER + SSD_GROUPS * SSD_STATE), axis=-1)
    xs = xs.reshape(b, seq, SSD_HEADS, SSD_HEAD_DIM)
    bmat = bmat.reshape(b, seq, SSD_GROUPS, SSD_STATE)
    cmat = cmat.reshape(b, seq, SSD_GROUPS, SSD_STATE)
    dt = jax.nn.softplus(dt_raw.astype(jnp.float32) + dt_bias.astype(jnp.float32))
    a_cont = -jnp.exp(a_log.astype(jnp.float32))
    x32 = xs.astype(jnp.float32)
    y = ssd_chunked_scan(x32 * dt[..., None], dt * a_cont, bmat, cmat)
    y = y + d_skip.astype(jnp.float32)[:, None] * x32
    y = y.reshape(b, seq, D_INNER).astype(h.dtype) * jax.nn.silu(z)
    y = rmsnorm(y.reshape(b, seq, SSD_GROUPS, D_INNER // SSD_GROUPS),
                ssd_norm_w.reshape(SSD_GROUPS, D_INNER // SSD_GROUPS))
    y_ssd = y.reshape(b, seq, D_INNER) @ w_branch_ssd
    y_pool = causal_multiscale_pool(u_pool, pool_w, pool_scale) @ w_branch_pool
    g_ssd, g_pool = jnp.split(jax.nn.sigmoid(gate_logits), N_BRANCHES, axis=-1)
    return (g_ssd * y_ssd + g_pool * y_pool) @ w_out


def setup_inputs(seed: int = 0) -> dict:
    key = jax.random.key(seed)
    ks = jax.random.split(key, 24)
    f32 = jnp.float32
    nrm = lambda k, shape, s: jax.random.normal(k, shape, f32) * s
    dt0 = jnp.exp(jax.random.uniform(ks[6], (DEPTH, SSD_HEADS), f32)
                  * (np.log(DT_MAX) - np.log(DT_MIN)) + np.log(DT_MIN))
    return {
        "x": nrm(ks[0], (BATCH, SEQ, D_MODEL), 1.0),
        "c": nrm(ks[1], (BATCH, D_MODEL), 1.0),
        "w_ada": nrm(ks[2], (DEPTH, D_MODEL, N_MOD * D_MODEL), D_MODEL ** -0.5),
        "b_ada": nrm(ks[3], (DEPTH, N_MOD * D_MODEL), 0.01),
        "norm_mix_w": 1.0 + nrm(ks[4], (DEPTH, D_MODEL), 0.05),
        "w_in": nrm(ks[5], (DEPTH, D_MODEL, IN_COLS), D_MODEL ** -0.5),
        "conv_w": nrm(ks[7], (DEPTH, CONV_WIDTH, XBC_WIDTH), CONV_WIDTH ** -0.5),
        "conv_b": nrm(ks[8], (DEPTH, XBC_WIDTH), 0.01),
        "dt_bias": dt0 + jnp.log(-jnp.expm1(-dt0)),
        "a_log": jnp.log(jax.random.uniform(ks[9], (DEPTH, SSD_HEADS), f32, 1.0, 16.0)),
        "d_skip": 1.0 + nrm(ks[10], (DEPTH, SSD_HEADS), 0.1),
        "ssd_norm_w": 1.0 + nrm(ks[11], (DEPTH, D_INNER), 0.05),
        "w_branch_ssd": nrm(ks[12], (DEPTH, D_INNER, D_MODEL), D_INNER ** -0.5),
        "pool_w": nrm(ks[13], (DEPTH, POOL_GROUPS, POOL_GROUP_WIDTH, POOL_GROUP_WIDTH), POOL_GROUP_WIDTH ** -0.5),
        "pool_scale": 1.0 + nrm(ks[14], (DEPTH, POOL_WIDTH), 0.1),
        "w_branch_pool": nrm(ks[15], (DEPTH, POOL_WIDTH, D_MODEL), POOL_WIDTH ** -0.5),
        "w_out": nrm(ks[16], (DEPTH, D_MODEL, D_MODEL), D_MODEL ** -0.5),
        "norm_mlp_w": 1.0 + nrm(ks[17], (DEPTH, D_MODEL), 0.05),
        "w_up": nrm(ks[18], (DEPTH, D_MODEL, D_FF), D_MODEL ** -0.5),
        "w_down": nrm(ks[19], (DEPTH, D_FF, D_MODEL), D_FF ** -0.5),
        "norm_final_w": 1.0 + nrm(ks[20], (D_MODEL,), 0.05),
    }


def reference(x, c, w_ada, b_ada, norm_mix_w, w_in, conv_w, conv_b, dt_bias, a_log, d_skip,
              ssd_norm_w, w_branch_ssd, pool_w, pool_scale, w_branch_pool, w_out,
              norm_mlp_w, w_up, w_down, norm_final_w):
    for i in range(DEPTH):
        mod = (jax.nn.silu(c) @ w_ada[i] + b_ada[i])[:, None, :]
        shift_m, scale_m, gate_m, shift_f, scale_f, gate_f = jnp.split(mod, N_MOD, axis=-1)
        h = rmsnorm(x, norm_mix_w[i]) * (1.0 + scale_m) + shift_m
        x = x + gate_m * hybrid_mixer(h, w_in[i], conv_w[i], conv_b[i], dt_bias[i], a_log[i],
                                      d_skip[i], ssd_norm_w[i], w_branch_ssd[i], pool_w[i],
                                      pool_scale[i], w_branch_pool[i], w_out[i])
        h = rmsnorm(x, norm_mlp_w[i]) * (1.0 + scale_f) + shift_f
        x = x + gate_f * (jnp.square(jax.nn.relu(h @ w_up[i])) @ w_down[i])
    return rmsnorm(x, norm_final_w)
```

```cpp
#include <hip/hip_runtime.h>
#include <hip/hip_cooperative_groups.h>
#include <cstdio>
#include <cstdint>
namespace cg = cooperative_groups;
namespace pg8 {
#define PG8_LAS __attribute__((address_space(3)))
typedef unsigned short bf16_t;
typedef short bf16x8 __attribute__((ext_vector_type(8)));
typedef float f32x4 __attribute__((ext_vector_type(4)));
typedef unsigned u32x4 __attribute__((ext_vector_type(4)));
constexpr int BM = 256, BK = 64, HALF = 128, HTB = HALF * BK * 2  , STAGE_BYTES = 8 * HTB, NXCD = 8, WGM = 8;

__host__ __device__ __forceinline__ int lds_byte(int r, int c) { const int st = (r >> 4) * 2 + (c >> 5), rr = r & 15, cc = c & 31, ob = rr * 64 + cc * 2; return st * 1024 + (ob ^ (((ob >> 9) & 1) << 5)); }
__host__ __device__ __forceinline__ void stage_rc(int b, int& R, int& C) { const int st = b / 1024, sb = b % 1024, swz = sb ^ (((sb >> 9) & 1) << 5); R = (st >> 1) * 16 + swz / 64; C = (st & 1) * 32 + (swz % 64) / 2; }
__host__ __device__ __forceinline__ int perm32(int rho) { const int n = rho >> 4, i = rho & 15; return 8 * (i >> 2) + 4 * n + (i & 3); }

struct Unit { int pm, pn; };
struct Gemm { const bf16_t* A; const bf16_t* Bt; int M, N, K; };

struct StaticOrder {
    int nM, nN, nwg, G, c;
    __host__ __device__ void init(int M, int N, int G_, int c_) { nM = M / BM; nN = N / BM; nwg = nM * nN; G = G_; c = c_; }
    __host__ __device__ bool next(int i, Unit& u) const {
        const long L = (long)i * G + c; if (L >= nwg) return false;
        int wgid = (int)L; { const int q = nwg / NXCD, r = nwg % NXCD, xcd = wgid % NXCD, off = wgid / NXCD; wgid = (xcd < r ? xcd * (q + 1) : r * (q + 1) + (xcd - r) * q) + off; }
        const int nig = WGM * nN, gid = wgid / nig, fm = gid * WGM, gsz = (nM - fm) < WGM ? (nM - fm) : WGM;
        u.pm = fm + ((wgid % nig) % gsz); u.pn = (wgid % nig) / gsz; return true;
    }
    __device__ __forceinline__ void a_ready(const Unit&) const {}
    __device__ __forceinline__ void done(const Unit&) const {}
};

typedef float f32x2c __attribute__((ext_vector_type(2))); typedef __bf16 bf16x2c __attribute__((ext_vector_type(2)));
__device__ __forceinline__ unsigned cvt_pk_bf16(float lo, float hi) { f32x2c v = {lo, hi}; bf16x2c b = __builtin_convertvector(v, bf16x2c); return __builtin_bit_cast(unsigned, b); }
template <int MODE> struct EpiMk {
    static constexpr bool PERM = true, AFTER_DRAIN = false;
    bf16_t* O0; bf16_t* O1; bf16_t* O2; bf16_t* halo; int ldc;
    const bf16_t* G; const bf16_t* YP; const float* X0; float* OF; const float* gate;
    __device__ __forceinline__ void operator()(const f32x4 (&acc)[2][2][4][2], const Unit& u, int wr, int wc, int fr, int fq) const {
        const int row0 = u.pm * BM + wr * 64 + fr;
        int colt = u.pn * BM; bf16_t* base = O0; int ld = ldc; bool dohalo = false;
        if constexpr (MODE == 0) {
            if (u.pn < 8) { base = O0; ld = 2048; }
            else if (u.pn < 20) { base = O1; ld = 3072; colt -= 2048; dohalo = true; }
            else { base = O2; ld = 1024; colt -= 5120; }
        }
        const int col0 = colt + wc * 32 + 8 * fq;
#pragma unroll
        for (int ai = 0; ai < 2; ++ai)
#pragma unroll
            for (int m = 0; m < 4; ++m) {
                const int row = row0 + ai * HALF + m * 16;
#pragma unroll
                for (int bj = 0; bj < 2; ++bj) {
                    const int col = col0 + bj * HALF;
                    f32x4 v0 = acc[ai][bj][m][0], v1 = acc[ai][bj][m][1];
                    if constexpr (MODE == 4) {
                        const float* gp = gate + (row >= 8192 ? 6144 : 0) + col;
                        const f32x4 g0 = *(const f32x4*)gp, g1 = *(const f32x4*)(gp + 4);
                        const float* xp = X0 + (size_t)row * ld + col;
                        const f32x4 x0 = *(const f32x4*)xp, x1 = *(const f32x4*)(xp + 4);
                        float* op = OF + (size_t)row * ld + col;
                        *(f32x4*)op = x0 + g0 * v0; *(f32x4*)(op + 4) = x1 + g1 * v1;
                    } else {
                        if constexpr (MODE == 1) {
#pragma unroll
                            for (int e = 0; e < 4; ++e) { v0[e] = 1.f / (1.f + __expf(-v0[e])); v1[e] = 1.f / (1.f + __expf(-v1[e])); }
                        }
                        if constexpr (MODE == 5) {
#pragma unroll
                            for (int e = 0; e < 4; ++e) { float a = fmaxf(v0[e], 0.f), b = fmaxf(v1[e], 0.f); v0[e] = a * a; v1[e] = b * b; }
                        }
                        if constexpr (MODE == 3) {
                            const u32x4 gs = *(const u32x4*)(G + (size_t)row * 2048 + col);
                            const u32x4 gq = *(const u32x4*)(G + (size_t)row * 2048 + 1024 + col);
                            const u32x4 yp = *(const u32x4*)(YP + (size_t)row * 1024 + col);
#pragma unroll
                            for (int e = 0; e < 2; ++e) {
                                v0[2 * e] = __builtin_bit_cast(float, gs[e] << 16) * v0[2 * e] + __builtin_bit_cast(float, gq[e] << 16) * __builtin_bit_cast(float, yp[e] << 16);
                                v0[2 * e + 1] = __builtin_bit_cast(float, gs[e] & 0xffff0000u) * v0[2 * e + 1] + __builtin_bit_cast(float, gq[e] & 0xffff0000u) * __builtin_bit_cast(float, yp[e] & 0xffff0000u);
                                v1[2 * e] = __builtin_bit_cast(float, gs[2 + e] << 16) * v1[2 * e] + __builtin_bit_cast(float, gq[2 + e] << 16) * __builtin_bit_cast(float, yp[2 + e] << 16);
                                v1[2 * e + 1] = __builtin_bit_cast(float, gs[2 + e] & 0xffff0000u) * v1[2 * e + 1] + __builtin_bit_cast(float, gq[2 + e] & 0xffff0000u) * __builtin_bit_cast(float, yp[2 + e] & 0xffff0000u);
                            }
                        }
                        u32x4 w; w.x = cvt_pk_bf16(v0[0], v0[1]); w.y = cvt_pk_bf16(v0[2], v0[3]); w.z = cvt_pk_bf16(v1[0], v1[1]); w.w = cvt_pk_bf16(v1[2], v1[3]);
                        *(u32x4*)(base + (size_t)row * ld + col) = w;
                        if constexpr (MODE == 0) {
                            if (dohalo && (row & 127) >= 125) *(u32x4*)(halo + ((size_t)(row >> 7) * 3 + ((row & 127) - 125)) * 3072 + col) = w;
                        }
                    }
                }
            }
    }
};


template <class Epi, class Sched, bool ALIGN_EPI = false, bool SP2 = false>
__device__ __forceinline__ void gemm_phase(PG8_LAS unsigned char* lds, const Gemm g, const Sched& S, const Epi& E) {
    const int tid = threadIdx.x, wid = __builtin_amdgcn_readfirstlane(tid >> 6), lane = tid & 63, wr = wid >> 2, wc = wid & 3, fr = lane & 15, fq = lane >> 4;
    const int K = g.K, nt = K / BK;
    unsigned voffA[2], voffB[2];
#pragma unroll
    for (int i = 0; i < 2; ++i) { int R, C; stage_rc(tid * 16 + i * 8192, R, C); const int Rb = Epi::PERM ? ((R & ~31) + perm32(R & 31)) : R;
        voffA[i] = (unsigned)(R * K + C) * 2u; voffB[i] = (unsigned)(Rb * K + C) * 2u; }
    const size_t kstep = (size_t)(BK * 2);
    const size_t hstep = (size_t)HALF * K * 2;
    const size_t tstep = 2 * hstep;
    const unsigned ldsw = (unsigned)wid * 1024u;
    const int aoff = lds_byte(wr * 64 + fr, fq * 8), boff = lds_byte(wc * 32 + fr, fq * 8);
#define PG8_SA(b, h) (((b) * 2 + (h)) * HTB)
#define PG8_SB(b, h) ((4 + (b) * 2 + (h)) * HTB)
#define PG8_STAGE(bufoff, gbase, voff) do { _Pragma("unroll") for (int _i = 0; _i < 2; ++_i) \
        __builtin_amdgcn_global_load_lds((const unsigned*)((const char*)(gbase) + (voff)[_i]), (PG8_LAS unsigned*)(lds + (bufoff) + ldsw + _i * 8192), 16, 0, 0); } while (0)
#define PG8_LDA(dst, b, h) do { _Pragma("unroll") for (int m = 0; m < 4; ++m) _Pragma("unroll") for (int k = 0; k < 2; ++k) dst[m][k] = *(const PG8_LAS bf16x8*)(lds + PG8_SA(b, h) + aoff + m * 2048 + k * 1024); } while (0)
#define PG8_LDB(dst, b, h) do { _Pragma("unroll") for (int n = 0; n < 2; ++n) _Pragma("unroll") for (int k = 0; k < 2; ++k) dst[n][k] = *(const PG8_LAS bf16x8*)(lds + PG8_SB(b, h) + boff + n * 2048 + k * 1024); } while (0)
#define PG8_MMA(ai, bj, At, Bt) do { __builtin_amdgcn_s_setprio(1); _Pragma("unroll") for (int m = 0; m < 4; ++m) _Pragma("unroll") for (int n = 0; n < 2; ++n) _Pragma("unroll") for (int k = 0; k < 2; ++k) \
        acc[ai][bj][m][n] = __builtin_amdgcn_mfma_f32_16x16x32_bf16(Bt[n][k], At[m][k], acc[ai][bj][m][n], 0, 0, 0); __builtin_amdgcn_s_setprio(0); } while (0)
#define PG8_WAIT_V(n) asm volatile("s_waitcnt vmcnt(" #n ")" ::: "memory")
#define PG8_WAIT_L(n) asm volatile("s_waitcnt lgkmcnt(" #n ")" ::: "memory")
#define PG8_BAR __builtin_amdgcn_s_barrier()
#define PG8_SCHED __builtin_amdgcn_sched_barrier(0)
    Unit cur, nxt; int ui = 0;
    if (!S.next(0, cur)) return;
    f32x4 acc[2][2][4][2];
#pragma unroll
    for (int a = 0; a < 2; ++a)
#pragma unroll
        for (int b = 0; b < 2; ++b)
#pragma unroll
            for (int m = 0; m < 4; ++m)
#pragma unroll
                for (int n = 0; n < 2; ++n) acc[a][b][m][n] = (f32x4){0.f, 0.f, 0.f, 0.f};
    bf16x8 At[4][2], B0[2][2], B1[2][2];
    const char* cA = (const char*)g.A + (size_t)cur.pm * tstep; const char* cB = (const char*)g.Bt + (size_t)cur.pn * tstep;
    S.a_ready(cur);
    if constexpr (SP2) {
        PG8_STAGE(PG8_SB(0, 0), cB, voffB); PG8_STAGE(PG8_SB(0, 1), cB + hstep, voffB); PG8_STAGE(PG8_SA(0, 0), cA, voffA); PG8_STAGE(PG8_SA(0, 1), cA + hstep, voffA);
        if (wr == 1) PG8_BAR;
        PG8_WAIT_V(2); PG8_BAR;
        PG8_STAGE(PG8_SB(1, 0), cB + kstep, voffB); PG8_STAGE(PG8_SA(1, 0), cA + kstep, voffA); PG8_STAGE(PG8_SB(1, 1), cB + hstep + kstep, voffB);
        PG8_WAIT_V(6); PG8_BAR;
    } else {
        PG8_STAGE(PG8_SB(0, 0), cB, voffB); PG8_STAGE(PG8_SA(0, 0), cA, voffA); PG8_STAGE(PG8_SB(0, 1), cB + hstep, voffB); PG8_STAGE(PG8_SA(0, 1), cA + hstep, voffA);
        if (wr == 1) PG8_BAR;
        PG8_WAIT_V(4); PG8_BAR;
        PG8_STAGE(PG8_SB(1, 0), cB + kstep, voffB); PG8_STAGE(PG8_SA(1, 0), cA + kstep, voffA); PG8_STAGE(PG8_SB(1, 1), cB + hstep + kstep, voffB);
        PG8_WAIT_V(6); PG8_BAR;
    }
    for (;;) {
        const bool has_next = S.next(ui + 1, nxt);
        const char* nA = has_next ? (const char*)g.A + (size_t)nxt.pm * tstep : cA; const char* nB = has_next ? (const char*)g.Bt + (size_t)nxt.pn * tstep : cB;
        for (int t = 0; t < nt; t += 2) {
            const bool last = (t == nt - 2);
            const char* a1 = cA + (size_t)(t + 1) * kstep;
            const char* a2 = last ? nA : cA + (size_t)(t + 2) * kstep; const char* b2 = last ? nB : cB + (size_t)(t + 2) * kstep;
            const char* a3 = a2 + kstep; const char* b3 = b2 + kstep;
            if (last && has_next) S.a_ready(nxt);
            if constexpr (SP2) {
            PG8_LDB(B0, 0, 0); PG8_LDB(B1, 0, 1); PG8_SCHED; PG8_LDA(At, 0, 0); PG8_STAGE(PG8_SA(1, 1), a1 + hstep, voffA);
            PG8_WAIT_V(8); PG8_WAIT_L(0); PG8_BAR; PG8_MMA(0, 0, At, B0); PG8_MMA(0, 1, At, B1); PG8_BAR; PG8_SCHED;
            PG8_LDA(At, 0, 1); PG8_STAGE(PG8_SB(0, 0), b2, voffB); PG8_STAGE(PG8_SB(0, 1), b2 + hstep, voffB); PG8_STAGE(PG8_SA(0, 0), a2, voffA);
            PG8_WAIT_V(8); PG8_WAIT_L(0); PG8_BAR; PG8_MMA(1, 0, At, B0); PG8_MMA(1, 1, At, B1); PG8_BAR; PG8_SCHED;
            PG8_LDB(B0, 1, 0); PG8_LDB(B1, 1, 1); PG8_SCHED; PG8_LDA(At, 1, 0); PG8_STAGE(PG8_SA(0, 1), a2 + hstep, voffA);
            PG8_WAIT_V(8); PG8_WAIT_L(0); PG8_BAR; PG8_MMA(0, 0, At, B0); PG8_MMA(0, 1, At, B1); PG8_BAR; PG8_SCHED;
            PG8_LDA(At, 1, 1); PG8_STAGE(PG8_SB(1, 0), b3, voffB); PG8_STAGE(PG8_SB(1, 1), b3 + hstep, voffB); PG8_STAGE(PG8_SA(1, 0), a3, voffA);
            PG8_WAIT_V(8); PG8_WAIT_L(0); PG8_BAR; PG8_MMA(1, 0, At, B0); PG8_MMA(1, 1, At, B1); PG8_BAR; PG8_SCHED;
            } else {
            PG8_LDB(B0, 0, 0); PG8_SCHED; PG8_LDA(At, 0, 0); PG8_STAGE(PG8_SA(1, 1), a1 + hstep, voffA);
            PG8_WAIT_L(8); PG8_BAR; PG8_WAIT_L(0); PG8_MMA(0, 0, At, B0); PG8_BAR; PG8_SCHED;
            PG8_LDB(B1, 0, 1); PG8_STAGE(PG8_SB(0, 0), b2, voffB);
            PG8_BAR; PG8_WAIT_L(0); PG8_MMA(0, 1, At, B1); PG8_BAR;
            PG8_LDA(At, 0, 1); PG8_STAGE(PG8_SA(0, 0), a2, voffA);
            PG8_BAR; PG8_WAIT_L(0); PG8_MMA(1, 0, At, B0); PG8_BAR; PG8_SCHED;
            PG8_STAGE(PG8_SB(0, 1), b2 + hstep, voffB);
            PG8_WAIT_V(6); PG8_BAR; PG8_MMA(1, 1, At, B1); PG8_BAR;
            PG8_LDB(B0, 1, 0); PG8_SCHED; PG8_LDA(At, 1, 0); PG8_STAGE(PG8_SA(0, 1), a2 + hstep, voffA);
            PG8_WAIT_L(8); PG8_BAR; PG8_WAIT_L(0); PG8_MMA(0, 0, At, B0); PG8_BAR; PG8_SCHED;
            PG8_LDB(B1, 1, 1); PG8_STAGE(PG8_SB(1, 0), b3, voffB);
            PG8_BAR; PG8_WAIT_L(0); PG8_MMA(0, 1, At, B1); PG8_BAR;
            PG8_LDA(At, 1, 1); PG8_STAGE(PG8_SA(1, 0), a3, voffA);
            PG8_BAR; PG8_WAIT_L(0); PG8_MMA(1, 0, At, B0); PG8_BAR; PG8_SCHED;
            PG8_STAGE(PG8_SB(1, 1), b3 + hstep, voffB);
            PG8_WAIT_V(6); PG8_BAR; PG8_MMA(1, 1, At, B1); PG8_BAR;
            }
        }
        if constexpr (ALIGN_EPI) { if (wr == 0) PG8_BAR; }
        if constexpr (!Epi::AFTER_DRAIN) { E(acc, cur, wr, wc, fr, fq); S.done(cur); }
        if (!has_next) break;
#pragma unroll
        for (int a = 0; a < 2; ++a)
#pragma unroll
            for (int b = 0; b < 2; ++b)
#pragma unroll
                for (int m = 0; m < 4; ++m)
#pragma unroll
                    for (int n = 0; n < 2; ++n) acc[a][b][m][n] = (f32x4){0.f, 0.f, 0.f, 0.f};
        cur = nxt; cA = nA; cB = nB; ++ui;
        if constexpr (ALIGN_EPI) { if (wr == 1) PG8_BAR; }
    }
    PG8_WAIT_V(0);
    if constexpr (!ALIGN_EPI) { if (wr == 0) PG8_BAR; }
    PG8_BAR;
    if constexpr (Epi::AFTER_DRAIN) { E.fused(acc, cur, wr, wc, fr, fq, lds, wid, lane); S.done(cur); }
#undef PG8_SA
#undef PG8_SB
#undef PG8_STAGE
#undef PG8_LDA
#undef PG8_LDB
#undef PG8_MMA
#undef PG8_WAIT_V
#undef PG8_WAIT_L
#undef PG8_BAR
#undef PG8_SCHED
}
}
#define LAS __attribute__((address_space(3)))
typedef unsigned short bf16;
typedef unsigned v4u __attribute__((ext_vector_type(4)));
typedef unsigned v2u __attribute__((ext_vector_type(2)));
typedef float f32x4 __attribute__((ext_vector_type(4)));
typedef short bf16x8 __attribute__((ext_vector_type(8)));
typedef short s16x4 __attribute__((ext_vector_type(4)));
typedef short v4i16_t __attribute__((ext_vector_type(4)));

constexpr int T = 16384, SEQ = 8192, D = 1024, DI = 2048, XW = 3072, FF = 4096, NH = 32, NMOD = 6144, INC = 8224;
constexpr float EPS = 1e-5f;
constexpr size_t MiB = 1u << 20;
constexpr size_t WS_WIN = 0, WS_WBSSD = 16 * MiB, WS_WPP = 20 * MiB, WS_WOUT = 22 * MiB, WS_WDT = 24 * MiB, WS_MOD = 24 * MiB + 65536;
constexpr size_t WS_DT = 25 * MiB, WS_ACS = 27 * MiB, WS_HALO = 29 * MiB;
constexpr size_t WS_XBC = 32 * MiB, WS_GATES = 32 * MiB, WS_UP = 32 * MiB;
constexpr size_t WS_H = 128 * MiB, WS_MERGED = 128 * MiB;
constexpr size_t WS_UPOOL = 160 * MiB, WS_YPOOL = 160 * MiB, WS_H2 = 160 * MiB;
constexpr size_t WS_POOLED = 192 * MiB, WS_STATES = 192 * MiB, WS_WUP = 192 * MiB, WS_WDOWN = 200 * MiB;
constexpr int LDS_BYTES = 147456;

typedef float f32x2_t __attribute__((ext_vector_type(2))); typedef __bf16 bf16x2_t __attribute__((ext_vector_type(2)));
__device__ __forceinline__ unsigned pk2(float lo, float hi) { f32x2_t v = {lo, hi}; bf16x2_t b = __builtin_convertvector(v, bf16x2_t); return __builtin_bit_cast(unsigned, b); }
__device__ __forceinline__ float bflo(unsigned u) { return __builtin_bit_cast(float, u << 16); }
__device__ __forceinline__ float bfhi(unsigned u) { return __builtin_bit_cast(float, u & 0xffff0000u); }
__device__ __forceinline__ float wave_sum(float v) {
#pragma unroll
    for (int o = 1; o < 64; o <<= 1) v += __shfl_xor(v, o);
    return v;
}
__device__ __forceinline__ float siluf(float v) { return v / (1.f + __expf(-v)); }
__device__ __forceinline__ s16x4 ds_tr(const unsigned char* p) { return __builtin_bit_cast(s16x4, __builtin_amdgcn_ds_read_tr16_b64_v4i16((LAS v4i16_t*)p)); }
__device__ __forceinline__ bf16x8 cat8(s16x4 a, s16x4 b) { return __builtin_shufflevector(a, b, 0, 1, 2, 3, 4, 5, 6, 7); }
#define MFMA16(a, b, c) __builtin_amdgcn_mfma_f32_16x16x32_bf16((a), (b), (c), 0, 0, 0)

__device__ __forceinline__ void transpose_item(const float* W, int ldw, int k0, int c0, bf16* WT, int K, int drow0, LAS float* scr, int lane) {
#pragma unroll 8
    for (int i = 0; i < 32; ++i) { const int kk = 2 * i + (lane >> 5); scr[kk * 33 + (lane & 31)] = W[(size_t)(k0 + kk) * ldw + c0 + (lane & 31)]; }
    asm volatile("s_waitcnt lgkmcnt(0)" ::: "memory");
    const int c = lane & 7;
#pragma unroll
    for (int j = 0; j < 4; ++j) { const int n = (lane >> 3) + 8 * j; const LAS float* s = scr + (8 * c) * 33 + n;
        v4u o; o.x = pk2(s[0 * 33], s[1 * 33]); o.y = pk2(s[2 * 33], s[3 * 33]); o.z = pk2(s[4 * 33], s[5 * 33]); o.w = pk2(s[6 * 33], s[7 * 33]);
        *(v4u*)(WT + (size_t)(drow0 + n) * K + k0 + 8 * c) = o; }
    asm volatile("s_waitcnt lgkmcnt(0)" ::: "memory");
}

__device__ __forceinline__ void norm_mod_row(const float* xrow, const float* w, const float* scale, const float* shift, bf16* orow, int lane) {
    const f32x4* xr = (const f32x4*)xrow + lane;
    f32x4 v[4]; float s = 0.f;
#pragma unroll
    for (int j = 0; j < 4; ++j) { v[j] = xr[64 * j]; s += (v[j].x * v[j].x + v[j].y * v[j].y) + (v[j].z * v[j].z + v[j].w * v[j].w); }
    const float rstd = rsqrtf(wave_sum(s) * (1.f / D) + EPS);
    v2u* o8 = (v2u*)orow + lane;
#pragma unroll
    for (int j = 0; j < 4; ++j) {
        const f32x4 ww = ((const f32x4*)w)[lane + 64 * j], sc = ((const f32x4*)scale)[lane + 64 * j], sh = ((const f32x4*)shift)[lane + 64 * j];
        f32x4 r = v[j] * rstd * ww * (sc + 1.f) + sh;
        v2u o; o.x = pk2(r.x, r.y); o.y = pk2(r.z, r.w); o8[64 * j] = o;
    }
}

struct Params { const float* in[21]; float* out; unsigned char* ws; };

__global__ void __launch_bounds__(512, 2) mk_fwd(Params P) {
    extern __shared__ __attribute__((aligned(16))) unsigned char lds[];
    cg::grid_group grid = cg::this_grid();
    const int tid = threadIdx.x, lane = tid & 63, wave = __builtin_amdgcn_readfirstlane(tid >> 6);
    const int G = gridDim.x, gw = blockIdx.x * 8 + wave, NGW = G * 8;
    unsigned char* ws = P.ws;
    const float* x = P.in[0]; const float* cvec = P.in[1]; const float* w_ada = P.in[2]; const float* b_ada = P.in[3]; const float* norm_mix_w = P.in[4];
    const float* w_in = P.in[5]; const float* conv_w = P.in[6]; const float* conv_b = P.in[7]; const float* dt_bias = P.in[8]; const float* a_log = P.in[9];
    const float* d_skip = P.in[10]; const float* ssd_norm_w = P.in[11]; const float* w_bssd = P.in[12]; const float* pool_w = P.in[13]; const float* pool_scale = P.in[14];
    const float* w_bpool = P.in[15]; const float* w_out = P.in[16]; const float* norm_mlp_w = P.in[17]; const float* w_up = P.in[18]; const float* w_down = P.in[19];
    const float* norm_final_w = P.in[20];
    bf16* Win_t = (bf16*)(ws + WS_WIN); bf16* Wbssd_t = (bf16*)(ws + WS_WBSSD); bf16* Wpp_t = (bf16*)(ws + WS_WPP); bf16* Wout_t = (bf16*)(ws + WS_WOUT);
    bf16* Wdt_t = (bf16*)(ws + WS_WDT); float* MOD = (float*)(ws + WS_MOD); float* DT = (float*)(ws + WS_DT); float* ACS = (float*)(ws + WS_ACS);
    bf16* HALO = (bf16*)(ws + WS_HALO); bf16* XBC = (bf16*)(ws + WS_XBC); bf16* GATES = (bf16*)(ws + WS_GATES); bf16* UPB = (bf16*)(ws + WS_UP);
    bf16* H = (bf16*)(ws + WS_H); bf16* MERGED = (bf16*)(ws + WS_MERGED); bf16* UPOOL = (bf16*)(ws + WS_UPOOL); bf16* YPOOL = (bf16*)(ws + WS_YPOOL);
    bf16* H2 = (bf16*)(ws + WS_H2); bf16* POOLED = (bf16*)(ws + WS_POOLED); bf16* STATES = (bf16*)(ws + WS_STATES); bf16* Wup_t = (bf16*)(ws + WS_WUP);
    bf16* Wdown_t = (bf16*)(ws + WS_WDOWN);
    bf16* Z = (bf16*)P.out;
    float* X1 = P.out;
    LAS unsigned char* gl = (LAS unsigned char*)lds;

    {
        LAS float* red = (LAS float*)gl;
        for (int it = blockIdx.x; it < 96; it += G) {
            const int j = it * 64 + lane; float a0 = 0.f, a1 = 0.f;
#pragma unroll 8
            for (int k = wave * 128; k < wave * 128 + 128; ++k) { const float w = w_ada[(size_t)k * NMOD + j]; a0 += siluf(cvec[k]) * w; a1 += siluf(cvec[1024 + k]) * w; }
            red[wave * 128 + lane] = a0; red[wave * 128 + 64 + lane] = a1; __syncthreads();
            if (tid < 128) { float s = 0.f;
#pragma unroll
                for (int q = 0; q < 8; ++q) s += red[q * 128 + tid];
                const int jj = it * 64 + (tid & 63); MOD[(tid >> 6) * NMOD + jj] = s + b_ada[jj]; }
            __syncthreads();
        }
        LAS float* scr = (LAS float*)(gl + wave * 16384);
        constexpr int I_IN = 16 * 257, I_BS = 32 * 32, I_O = 16 * 32;
        for (int it = gw; it < I_IN + I_BS + I_O; it += NGW) {
            int r = it;
            if (r < I_IN) { const int kb = r / 257, nb = r % 257; const int c0 = nb * 32;
                if (nb == 160) transpose_item(w_in, INC, kb * 64, c0, Wdt_t, D, 0, scr, lane);
                else transpose_item(w_in, INC, kb * 64, c0, Win_t, D, nb < 160 ? c0 : c0 - 32, scr, lane);
                continue; } r -= I_IN;
            if (r < I_BS) { transpose_item(w_bssd, D, (r / 32) * 64, (r % 32) * 32, Wbssd_t, DI, (r % 32) * 32, scr, lane); continue; } r -= I_BS;
            transpose_item(w_out, D, (r / 32) * 64, (r % 32) * 32, Wout_t, D, (r % 32) * 32, scr, lane);
        }
        for (int e = blockIdx.x * 512 + tid; e < D * D; e += G * 512) {
            const int n = e & 1023, k = e >> 10, g = k >> 8; const float* pw = pool_w + (size_t)k * 256; const float* ps = pool_scale + g * 256; const float* wb = w_bpool + (size_t)g * 256 * D + n;
            float a = 0.f;
#pragma unroll 8
            for (int j = 0; j < 256; ++j) a += pw[j] * ps[j] * wb[(size_t)j * D];
            Wpp_t[(size_t)n * D + k] = (bf16)(pk2(a, 0.f) & 0xffffu);
        }
    }
    grid.sync();
    for (int m = gw; m < T; m += NGW) { const float* md = MOD + (m >> 13) * NMOD; norm_mod_row(x + (size_t)m * D, norm_mix_w, md + 1024, md, H + (size_t)m * D, lane); }
    grid.sync();
    {
        pg8::Gemm g{H, Win_t, T, 6144, D}; pg8::StaticOrder S; S.init(T, 6144, G, (int)blockIdx.x);
        pg8::EpiMk<0> E{}; E.O0 = Z; E.O1 = XBC; E.O2 = UPOOL; E.halo = HALO; E.ldc = 0;
        pg8::gemm_phase<pg8::EpiMk<0>, pg8::StaticOrder, true, true>(gl, g, S, E);
        const int gq = lane >> 4, i = lane & 15;
        for (int it = gw; it < T / 16; it += NGW) {
            const int r0 = it * 16; f32x4 a0 = {0.f, 0.f, 0.f, 0.f}, a1 = {0.f, 0.f, 0.f, 0.f};
#pragma unroll 4
            for (int ks = 0; ks < 32; ++ks) {
                const bf16x8 af = *(const bf16x8*)(H + (size_t)(r0 + i) * D + 32 * ks + 8 * gq);
                const bf16x8 b0 = *(const bf16x8*)(Wdt_t + (size_t)i * D + 32 * ks + 8 * gq), b1 = *(const bf16x8*)(Wdt_t + (size_t)(16 + i) * D + 32 * ks + 8 * gq);
                a0 = MFMA16(af, b0, a0); a1 = MFMA16(af, b1, a1);
            }
#pragma unroll
            for (int r = 0; r < 4; ++r) { DT[(size_t)(r0 + 4 * gq + r) * NH + i] = a0[r]; DT[(size_t)(r0 + 4 * gq + r) * NH + 16 + i] = a1[r]; }
        }
    }
    grid.sync();
    {
        const int tx = tid & 63, ty = tid >> 6;
        for (int it = blockIdx.x; it < 768; it += G) {
            const int ch = it / 6, cb = it % 6; const int ch0 = cb * 512 + tx * 8; const size_t row0 = (size_t)ch * 128 + ty * 16;
            v4u raw[19];
#pragma unroll
            for (int r = 0; r < 16; ++r) raw[3 + r] = *(const v4u*)(XBC + (row0 + r) * XW + ch0);
            if (ty > 0) {
#pragma unroll
                for (int r = 0; r < 3; ++r) raw[r] = *(const v4u*)(XBC + (row0 - 3 + r) * XW + ch0);
            } else if ((ch & 63) != 0) {
#pragma unroll
                for (int r = 0; r < 3; ++r) raw[r] = *(const v4u*)(HALO + ((size_t)(ch - 1) * 3 + r) * XW + ch0);
            } else {
#pragma unroll
                for (int r = 0; r < 3; ++r) raw[r] = (v4u){0u, 0u, 0u, 0u};
            }
            asm volatile("s_waitcnt vmcnt(0)" ::: "memory"); __syncthreads();
            float wv[4][8], bv[8];
#pragma unroll
            for (int k = 0; k < 4; ++k) { const f32x4 a = *(const f32x4*)(conv_w + (size_t)k * XW + ch0), b = *(const f32x4*)(conv_w + (size_t)k * XW + ch0 + 4);
                wv[k][0] = a.x; wv[k][1] = a.y; wv[k][2] = a.z; wv[k][3] = a.w; wv[k][4] = b.x; wv[k][5] = b.y; wv[k][6] = b.z; wv[k][7] = b.w; }
            { const f32x4 a = *(const f32x4*)(conv_b + ch0), b = *(const f32x4*)(conv_b + ch0 + 4); bv[0] = a.x; bv[1] = a.y; bv[2] = a.z; bv[3] = a.w; bv[4] = b.x; bv[5] = b.y; bv[6] = b.z; bv[7] = b.w; }
#pragma unroll
            for (int r = 0; r < 16; ++r) {
                v4u o;
#pragma unroll
                for (int e = 0; e < 4; ++e) {
                    float lo = bv[2 * e], hi = bv[2 * e + 1];
#pragma unroll
                    for (int k = 0; k < 4; ++k) { const unsigned u = raw[r + k][e]; lo += wv[k][2 * e] * bflo(u); hi += wv[k][2 * e + 1] * bfhi(u); }
                    o[e] = pk2(siluf(lo), siluf(hi));
                }
                *(v4u*)(XBC + (row0 + r) * XW + ch0) = o;
            }
        }
        for (int e = blockIdx.x * 512 + tid; e < T * 128; e += G * 512) {
            const int t = e >> 7, c8 = (e & 127) * 8, gi = c8 >> 8, win = 2 << gi, pos = t & (SEQ - 1); const int cnt = (pos + 1 < win) ? pos + 1 : win;
            float s[8], u0[8];
#pragma unroll
            for (int q = 0; q < 8; ++q) s[q] = 0.f;
            for (int j = 0; j < cnt; ++j) { const v4u v = *(const v4u*)(UPOOL + (size_t)(t - j) * D + c8);
#pragma unroll
                for (int q = 0; q < 4; ++q) { const float lo = bflo(v[q]), hi = bfhi(v[q]); s[2 * q] += lo; s[2 * q + 1] += hi; if (j == 0) { u0[2 * q] = lo; u0[2 * q + 1] = hi; } } }
            const float inv = 1.f / (float)cnt; v4u o;
#pragma unroll
            for (int q = 0; q < 4; ++q) o[q] = pk2(s[2 * q] * inv - u0[2 * q], s[2 * q + 1] * inv - u0[2 * q + 1]);
            *(v4u*)(POOLED + (size_t)t * D + c8) = o;
        }
        for (int it = gw; it < 128 * NH; it += NGW) {
            const int ch = it >> 5, h = it & 31; const size_t r0 = (size_t)ch * 128 + 2 * lane; const float bias = dt_bias[h], A = -__expf(a_log[h]);
            float v0 = DT[r0 * NH + h] + bias, v1 = DT[(r0 + 1) * NH + h] + bias;
            const float d0 = v0 > 20.f ? v0 : log1pf(__expf(v0)), d1 = v1 > 20.f ? v1 : log1pf(__expf(v1));
            const float a0 = d0 * A, a1 = d1 * A; float incl = a0 + a1;
#pragma unroll
            for (int o = 1; o < 64; o <<= 1) { const float n = __shfl_up(incl, o); if (lane >= o) incl += n; }
            const float excl = incl - (a0 + a1);
            DT[r0 * NH + h] = d0; DT[(r0 + 1) * NH + h] = d1; ACS[r0 * NH + h] = excl + a0; ACS[(r0 + 1) * NH + h] = excl + a0 + a1;
        }
    }
    grid.sync();
    {
        pg8::Gemm g{POOLED, Wpp_t, T, D, D}; pg8::StaticOrder S; S.init(T, D, G, (int)blockIdx.x);
        pg8::EpiMk<2> E{}; E.O0 = YPOOL; E.ldc = D;
        pg8::gemm_phase<pg8::EpiMk<2>, pg8::StaticOrder, true, true>(gl, g, S, E);
    }

#if defined(PROBE_STOP) && PROBE_STOP == 1
    grid.sync();
    for (int m = gw; m < T; m += NGW) {
        for (int j = 0; j < 16; ++j) { const int c = lane + 64 * j;
            float v = bflo((unsigned)XBC[(size_t)m * XW + c]) + bflo((unsigned)XBC[(size_t)m * XW + 2048 + c]) + bflo((unsigned)YPOOL[(size_t)m * D + c]) + ACS[(size_t)m * NH + (c & 31)] + DT[(size_t)m * NH + (c & 31)];
            P.out[(size_t)m * D + c] = v; }
    }
    return;
#endif
    grid.sync();
    const int gq = lane >> 4, li = lane & 15, lr = li >> 2, lc = li & 3;
    {
        unsigned char* ldsB = lds; unsigned char* ldsX = lds + 34816;
        for (int it = blockIdx.x; it < 512; it += G) {
            const int bc = it >> 2, g = it & 3; const size_t row0 = (size_t)bc * 128;
            for (int q = tid; q < 2048; q += 512) { const int r = q >> 4, c16 = q & 15; *(v4u*)(ldsB + r * 272 + c16 * 16) = *(const v4u*)(XBC + (row0 + r) * XW + 2048 + g * 128 + c16 * 8); }
            __syncthreads();
            bf16x8 Af[4];
#pragma unroll
            for (int ks = 0; ks < 4; ++ks) Af[ks] = cat8(ds_tr(ldsB + (32 * ks + 8 * gq + lr) * 272 + (16 * wave + 4 * lc) * 2), ds_tr(ldsB + (32 * ks + 8 * gq + 4 + lr) * 272 + (16 * wave + 4 * lc) * 2));
#pragma unroll 1
            for (int hh = 0; hh < 8; ++hh) {
                const int h = 8 * g + hh;
                { const int r = tid >> 2, qc = tid & 3;
                  const float sc = DT[(row0 + r) * NH + h] * __expf(ACS[(row0 + 127) * NH + h] - ACS[(row0 + r) * NH + h]);
#pragma unroll
                  for (int e = 0; e < 2; ++e) { const v4u v = *(const v4u*)(XBC + (row0 + r) * XW + h * 64 + qc * 16 + e * 8); v4u o;
#pragma unroll
                      for (int q = 0; q < 4; ++q) o[q] = pk2(bflo(v[q]) * sc, bfhi(v[q]) * sc);
                      *(v4u*)(ldsX + r * 144 + (qc * 16 + e * 8) * 2) = o; } }
                __syncthreads();
                f32x4 acc[4];
#pragma unroll
                for (int pt = 0; pt < 4; ++pt) acc[pt] = (f32x4){0.f, 0.f, 0.f, 0.f};
#pragma unroll
                for (int ks = 0; ks < 4; ++ks)
#pragma unroll
                    for (int pt = 0; pt < 4; ++pt) {
                        const bf16x8 bx = cat8(ds_tr(ldsX + (32 * ks + 8 * gq + lr) * 144 + (16 * pt + 4 * lc) * 2), ds_tr(ldsX + (32 * ks + 8 * gq + 4 + lr) * 144 + (16 * pt + 4 * lc) * 2));
                        acc[pt] = MFMA16(Af[ks], bx, acc[pt]);
                    }
                bf16* st = STATES + ((size_t)bc * NH + h) * 8192;
#pragma unroll
                for (int pt = 0; pt < 4; ++pt) { v2u o; o.x = pk2(acc[pt][0], acc[pt][1]); o.y = pk2(acc[pt][2], acc[pt][3]); *(v2u*)(st + (16 * pt + li) * 128 + 16 * wave + 4 * gq) = o; }
                __syncthreads();
            }
        }
    }
    grid.sync();
    for (int e = blockIdx.x * 512 + tid; e < 131072; e += G * 512) {
        const int n4 = e & 31, p = (e >> 5) & 63, h = (e >> 11) & 31, b = e >> 16;
        float s0 = 0.f, s1 = 0.f, s2 = 0.f, s3 = 0.f;
#pragma unroll 8
        for (int c = 0; c < 64; ++c) {
            v2u* ptr = (v2u*)(STATES + (((size_t)(b * 64 + c) * NH + h) * 64 + p) * 128 + n4 * 4);
            const v2u v = *ptr; const float d = __expf(ACS[((size_t)b * SEQ + c * 128 + 127) * NH + h]);
            v2u o; o.x = pk2(s0, s1); o.y = pk2(s2, s3); *ptr = o;
            s0 = s0 * d + bflo(v.x); s1 = s1 * d + bfhi(v.x); s2 = s2 * d + bflo(v.y); s3 = s3 * d + bfhi(v.y);
        }
    }

#if defined(PROBE_STOP) && PROBE_STOP == 3
    grid.sync();
    for (size_t e = (size_t)blockIdx.x * 512 + tid; e < (size_t)T * D; e += (size_t)G * 512) { const unsigned u = ((const unsigned*)STATES)[e]; P.out[e] = bflo(u) + bfhi(u); }
    return;
#endif
    grid.sync();
    {
        unsigned char* ldsC = lds; unsigned char* ldsB = lds + 34816; unsigned char* ldsX0 = lds + 69632; float* ldsA = (float*)(lds + 106496); float* ldsD = (float*)(lds + 110592);
        for (int it = blockIdx.x; it < 512; it += G) {
            const int bc = it >> 2, g = it & 3; const size_t row0 = (size_t)bc * 128;
            for (int q = tid; q < 2048; q += 512) { const int r = q >> 4, c16 = q & 15;
                *(v4u*)(ldsB + r * 272 + c16 * 16) = *(const v4u*)(XBC + (row0 + r) * XW + 2048 + g * 128 + c16 * 8);
                *(v4u*)(ldsC + r * 272 + c16 * 16) = *(const v4u*)(XBC + (row0 + r) * XW + 2560 + g * 128 + c16 * 8); }
            for (int q = tid; q < 1024; q += 512) { const int hh = q >> 7, r = q & 127; ldsA[q] = ACS[(row0 + r) * NH + 8 * g + hh]; ldsD[q] = DT[(row0 + r) * NH + 8 * g + hh]; }
            const int xr = tid >> 2, xq = tid & 3;
            { const bf16* src = XBC + (row0 + xr) * XW + (8 * g) * 64 + xq * 16; *(v4u*)(ldsX0 + xr * 144 + xq * 32) = *(const v4u*)src; *(v4u*)(ldsX0 + xr * 144 + xq * 32 + 16) = *(const v4u*)(src + 8); }
            __syncthreads();
            bf16x8 Cf[4];
#pragma unroll
            for (int ks = 0; ks < 4; ++ks) Cf[ks] = *(const bf16x8*)(ldsC + (16 * wave + li) * 272 + (32 * ks + 8 * gq) * 2);
            f32x4 sc[8];
#pragma unroll
            for (int st = 0; st < 8; ++st) { sc[st] = (f32x4){0.f, 0.f, 0.f, 0.f};
                if (st <= wave) {
#pragma unroll
                    for (int ks = 0; ks < 4; ++ks) { const bf16x8 af = *(const bf16x8*)(ldsB + (16 * st + li) * 272 + (32 * ks + 8 * gq) * 2); sc[st] = MFMA16(af, Cf[ks], sc[st]); }
                } }
            const int lrow = 16 * wave + li;
            float ssq = 0.f;
            bool dmask[4];
#pragma unroll
            for (int r = 0; r < 4; ++r) dmask[r] = (4 * gq + r <= li);
#pragma unroll 1
            for (int hh = 0; hh < 8; ++hh) {
                const int h = 8 * g + hh; unsigned char* ldsX = ldsX0 + (hh & 1) * 18432; unsigned char* ldsXn = ldsX0 + ((hh + 1) & 1) * 18432;
                const float* aA = ldsA + hh * 128; const float* aD = ldsD + hh * 128;
                v4u nx0 = {0u, 0u, 0u, 0u}, nx1 = {0u, 0u, 0u, 0u};
                if (hh < 7) { const bf16* src = XBC + (row0 + xr) * XW + (h + 1) * 64 + xq * 16; nx0 = *(const v4u*)src; nx1 = *(const v4u*)(src + 8); }
                const float al = aA[lrow];
                f32x4 acc[4];
                const bf16* prev = STATES + ((size_t)bc * NH + h) * 8192;
#pragma unroll
                for (int pt = 0; pt < 4; ++pt) { acc[pt] = (f32x4){0.f, 0.f, 0.f, 0.f};
#pragma unroll
                    for (int ks = 0; ks < 4; ++ks) { const bf16x8 ap = *(const bf16x8*)(prev + (16 * pt + li) * 128 + 32 * ks + 8 * gq); acc[pt] = MFMA16(ap, Cf[ks], acc[pt]); } }
                const float el = __expf(al);
#pragma unroll
                for (int pt = 0; pt < 4; ++pt) acc[pt] = acc[pt] * el;
#pragma unroll
                for (int q = 0; q < 4; ++q) {
                    if (2 * q <= wave) {
                        const f32x4 as0 = *(const f32x4*)(aA + 32 * q + 4 * gq), as1 = *(const f32x4*)(aA + 32 * q + 16 + 4 * gq);
                        const f32x4 dd0 = *(const f32x4*)(aD + 32 * q + 4 * gq), dd1 = *(const f32x4*)(aD + 32 * q + 16 + 4 * gq);
                        float mv[8];
#pragma unroll
                        for (int r = 0; r < 4; ++r) {
                            float v0 = sc[2 * q][r] * (__expf(fminf(al - as0[r], 0.f)) * dd0[r]);
                            float v1 = sc[2 * q + 1][r] * (__expf(fminf(al - as1[r], 0.f)) * dd1[r]);
                            if (2 * q == wave && !dmask[r]) v0 = 0.f;
                            if (2 * q + 1 == wave && !dmask[r]) v1 = 0.f;
                            mv[r] = v0; mv[4 + r] = v1;
                        }
                        v4u mp; mp.x = pk2(mv[0], mv[1]); mp.y = pk2(mv[2], mv[3]); mp.z = pk2(mv[4], mv[5]); mp.w = pk2(mv[6], mv[7]);
                        const bf16x8 Mf = __builtin_bit_cast(bf16x8, mp);
#pragma unroll
                        for (int pt = 0; pt < 4; ++pt) {
                            const bf16x8 ax = cat8(ds_tr(ldsX + (32 * q + 4 * gq + lr) * 144 + (16 * pt + 4 * lc) * 2), ds_tr(ldsX + (32 * q + 16 + 4 * gq + lr) * 144 + (16 * pt + 4 * lc) * 2));
                            acc[pt] = MFMA16(ax, Mf, acc[pt]);
                        }
                    }
                }
                const float Dh = d_skip[h];
#pragma unroll
                for (int pt = 0; pt < 4; ++pt) {
                    const int p0 = 16 * pt + 4 * gq;
                    const v2u xv = *(const v2u*)(ldsX + lrow * 144 + p0 * 2);
                    v2u* zp = (v2u*)(Z + (row0 + lrow) * DI + h * 64 + p0);
                    const v2u zv = *zp;
                    const float y0 = (acc[pt][0] + Dh * bflo(xv.x)) * siluf(bflo(zv.x)), y1 = (acc[pt][1] + Dh * bfhi(xv.x)) * siluf(bfhi(zv.x));
                    const float y2 = (acc[pt][2] + Dh * bflo(xv.y)) * siluf(bflo(zv.y)), y3 = (acc[pt][3] + Dh * bfhi(xv.y)) * siluf(bfhi(zv.y));
                    ssq += (y0 * y0 + y1 * y1) + (y2 * y2 + y3 * y3);
                    v2u o; o.x = pk2(y0, y1); o.y = pk2(y2, y3); *zp = o;
                }
                if (hh < 7) { *(v4u*)(ldsXn + xr * 144 + xq * 32) = nx0; *(v4u*)(ldsXn + xr * 144 + xq * 32 + 16) = nx1; }
                __syncthreads();
            }
            ssq += __shfl_xor(ssq, 16); ssq += __shfl_xor(ssq, 32);
            const float rstd = rsqrtf(ssq * (1.f / 512.f) + EPS);
#pragma unroll 1
            for (int hh = 0; hh < 8; ++hh)
#pragma unroll
                for (int pt = 0; pt < 4; ++pt) {
                    const int chn = 512 * g + 64 * hh + 16 * pt + 4 * gq; const f32x4 nw = *(const f32x4*)(ssd_norm_w + chn);
                    v2u* zp = (v2u*)(Z + (row0 + lrow) * DI + chn); const v2u yv = *zp;
                    v2u o; o.x = pk2(bflo(yv.x) * rstd * nw.x, bfhi(yv.x) * rstd * nw.y); o.y = pk2(bflo(yv.y) * rstd * nw.z, bfhi(yv.y) * rstd * nw.w);
                    *zp = o;
                }
            __syncthreads();
        }
    }

#if defined(PROBE_STOP) && PROBE_STOP == 2
    grid.sync();
    for (int m = gw; m < T; m += NGW) {
        float v[16];
#pragma unroll
        for (int j = 0; j < 16; ++j) { const int c = lane + 64 * j; v[j] = bflo((unsigned)Z[(size_t)m * DI + c]) + bflo((unsigned)Z[(size_t)m * DI + 1024 + c]); }
        asm volatile("s_waitcnt vmcnt(0)" ::: "memory");
#pragma unroll
        for (int j = 0; j < 16; ++j) { const int c = lane + 64 * j; P.out[(size_t)m * D + c] = v[j]; }
    }
    return;
#endif
    grid.sync();
    {
        pg8::Gemm g{H, Win_t + (size_t)6144 * D, T, 2048, D}; pg8::StaticOrder S; S.init(T, 2048, G, (int)blockIdx.x);
        pg8::EpiMk<1> E{}; E.O0 = GATES; E.ldc = 2048;
        pg8::gemm_phase<pg8::EpiMk<1>, pg8::StaticOrder, true, true>(gl, g, S, E);
        LAS float* scr = (LAS float*)(gl + wave * 16384);
        for (int it = gw; it < 4096; it += NGW) {
            if (it < 2048) transpose_item(w_up, FF, (it / 128) * 64, (it % 128) * 32, Wup_t, D, (it % 128) * 32, scr, lane);
            else { const int r = it - 2048; transpose_item(w_down, D, (r / 32) * 64, (r % 32) * 32, Wdown_t, FF, (r % 32) * 32, scr, lane); }
        }
    }
    grid.sync();
    {
        pg8::Gemm g{Z, Wbssd_t, T, D, DI}; pg8::StaticOrder S; S.init(T, D, G, (int)blockIdx.x);
        pg8::EpiMk<3> E{}; E.O0 = MERGED; E.ldc = D; E.G = GATES; E.YP = YPOOL;
        pg8::gemm_phase<pg8::EpiMk<3>, pg8::StaticOrder, true, true>(gl, g, S, E);
    }
    grid.sync();
    {
        pg8::Gemm g{MERGED, Wout_t, T, D, D}; pg8::StaticOrder S; S.init(T, D, G, (int)blockIdx.x);
        pg8::EpiMk<4> E{}; E.ldc = D; E.X0 = x; E.OF = X1; E.gate = MOD + 2048;
        pg8::gemm_phase<pg8::EpiMk<4>, pg8::StaticOrder, true, true>(gl, g, S, E);
    }
    grid.sync();
    for (int m = gw; m < T; m += NGW) { const float* md = MOD + (m >> 13) * NMOD; norm_mod_row(X1 + (size_t)m * D, norm_mlp_w, md + 4096, md + 3072, H2 + (size_t)m * D, lane); }
    grid.sync();
    {
        pg8::Gemm g{H2, Wup_t, T, FF, D}; pg8::StaticOrder S; S.init(T, FF, G, (int)blockIdx.x);
        pg8::EpiMk<5> E{}; E.O0 = UPB; E.ldc = FF;
        pg8::gemm_phase<pg8::EpiMk<5>, pg8::StaticOrder, true, true>(gl, g, S, E);
    }
    grid.sync();
    {
        pg8::Gemm g{UPB, Wdown_t, T, D, FF}; pg8::StaticOrder S; S.init(T, D, G, (int)blockIdx.x);
        pg8::EpiMk<4> E{}; E.ldc = D; E.X0 = X1; E.OF = X1; E.gate = MOD + 5120;
        pg8::gemm_phase<pg8::EpiMk<4>, pg8::StaticOrder, true, true>(gl, g, S, E);
    }
    grid.sync();
    for (int m = gw; m < T; m += NGW) {
        f32x4* xr = (f32x4*)(X1 + (size_t)m * D) + lane; f32x4 v[4]; float s = 0.f;
#pragma unroll
        for (int j = 0; j < 4; ++j) { v[j] = xr[64 * j]; s += (v[j].x * v[j].x + v[j].y * v[j].y) + (v[j].z * v[j].z + v[j].w * v[j].w); }
        const float rstd = rsqrtf(wave_sum(s) * (1.f / D) + EPS);
#pragma unroll
        for (int j = 0; j < 4; ++j) xr[64 * j] = v[j] * rstd * ((const f32x4*)norm_final_w)[lane + 64 * j];
    }
}

extern "C" void kernel_launch(void* const* d_in, const int* in_sizes, int n_in, void* d_out, int out_size, void* d_ws, size_t ws_size, hipStream_t stream) {
    static int grid_blocks = 0;
    if (!grid_blocks) {
        int dev = 0, cus = 0, per_cu = 0;
        hipGetDevice(&dev);
        hipDeviceGetAttribute(&cus, hipDeviceAttributeMultiprocessorCount, dev);
        hipFuncSetAttribute((const void*)mk_fwd, hipFuncAttributeMaxDynamicSharedMemorySize, LDS_BYTES);
        hipOccupancyMaxActiveBlocksPerMultiprocessor(&per_cu, (const void*)mk_fwd, 512, LDS_BYTES);
        if (per_cu < 1) { fprintf(stderr, "occupancy query reports %d blocks/CU\n", per_cu); per_cu = 1; }
        grid_blocks = cus * 1;
        if (n_in != 21 || ws_size < 256 * MiB) fprintf(stderr, "kernel_launch: unexpected n_in %d / ws_size %zu\n", n_in, ws_size);
    }
    Params p{};
    for (int i = 0; i < 21; ++i) p.in[i] = (const float*)d_in[i];
    p.out = (float*)d_out; p.ws = (unsigned char*)d_ws;
    void* args[] = {&p};
    hipError_t e = hipLaunchCooperativeKernel((const void*)mk_fwd, dim3(grid_blocks), dim3(512), args, LDS_BYTES, stream);
    if (e != hipSuccess) fprintf(stderr, "cooperative launch failed: %s (grid %d)\n", hipGetErrorString(e), grid_blocks);
}
```

```cpp
#include <hip/hip_runtime.h>
#include <hip/hip_cooperative_groups.h>
#include <cstdio>
#include <cstdint>
namespace cg = cooperative_groups;
#ifndef DUP_PH
#define DUP_PH -1
#endif
#define DRY(n) (((DUP_PH) == (n)) && rep_ == 0)
#define REP(n) for (int rep_ = 0; rep_ < ((DUP_PH) == (n) ? 2 : 1); ++rep_)
namespace pg8 {
#define PG8_LAS __attribute__((address_space(3)))
typedef unsigned short bf16_t;
typedef short bf16x8 __attribute__((ext_vector_type(8)));
typedef float f32x4 __attribute__((ext_vector_type(4)));
typedef unsigned u32x4 __attribute__((ext_vector_type(4)));
constexpr int BM = 256, BK = 64, HALF = 128, HTB = HALF * BK * 2  , STAGE_BYTES = 8 * HTB, NXCD = 8, WGM = 8;

__host__ __device__ __forceinline__ int lds_byte(int r, int c) { const int st = (r >> 4) * 2 + (c >> 5), rr = r & 15, cc = c & 31, ob = rr * 64 + cc * 2; return st * 1024 + (ob ^ (((ob >> 9) & 1) << 5)); }
__host__ __device__ __forceinline__ void stage_rc(int b, int& R, int& C) { const int st = b / 1024, sb = b % 1024, swz = sb ^ (((sb >> 9) & 1) << 5); R = (st >> 1) * 16 + swz / 64; C = (st & 1) * 32 + (swz % 64) / 2; }
__host__ __device__ __forceinline__ int perm32(int rho) { const int n = rho >> 4, i = rho & 15; return 8 * (i >> 2) + 4 * n + (i & 3); }

struct Unit { int pm, pn; };
struct Gemm { const bf16_t* A; const bf16_t* Bt; int M, N, K; };

struct StaticOrder {
    int nM, nN, nwg, G, c;
    __host__ __device__ void init(int M, int N, int G_, int c_) { nM = M / BM; nN = N / BM; nwg = nM * nN; G = G_; c = c_; }
    __host__ __device__ bool next(int i, Unit& u) const {
        const long L = (long)i * G + c; if (L >= nwg) return false;
        int wgid = (int)L; { const int q = nwg / NXCD, r = nwg % NXCD, xcd = wgid % NXCD, off = wgid / NXCD; wgid = (xcd < r ? xcd * (q + 1) : r * (q + 1) + (xcd - r) * q) + off; }
        const int nig = WGM * nN, gid = wgid / nig, fm = gid * WGM, gsz = (nM - fm) < WGM ? (nM - fm) : WGM;
        u.pm = fm + ((wgid % nig) % gsz); u.pn = (wgid % nig) / gsz; return true;
    }
    __device__ __forceinline__ void a_ready(const Unit&) const {}
    __device__ __forceinline__ void done(const Unit&) const {}
};

typedef float f32x2c __attribute__((ext_vector_type(2))); typedef __bf16 bf16x2c __attribute__((ext_vector_type(2)));
__device__ __forceinline__ unsigned cvt_pk_bf16(float lo, float hi) { f32x2c v = {lo, hi}; bf16x2c b = __builtin_convertvector(v, bf16x2c); return __builtin_bit_cast(unsigned, b); }
template <int MODE> struct EpiMk {
    static constexpr bool PERM = true, AFTER_DRAIN = false;
    bf16_t* O0; bf16_t* O1; bf16_t* O2; bf16_t* halo; int ldc;
    const bf16_t* G; const bf16_t* YP; const float* X0; float* OF; const float* gate;
    __device__ __forceinline__ void operator()(const f32x4 (&acc)[2][2][4][2], const Unit& u, int wr, int wc, int fr, int fq) const {
        const int row0 = u.pm * BM + wr * 64 + fr;
        int colt = u.pn * BM; bf16_t* base = O0; int ld = ldc; bool dohalo = false;
        if constexpr (MODE == 0) {
            if (u.pn < 8) { base = O0; ld = 2048; }
            else if (u.pn < 20) { base = O1; ld = 3072; colt -= 2048; dohalo = true; }
            else { base = O2; ld = 1024; colt -= 5120; }
        }
        const int col0 = colt + wc * 32 + 8 * fq;
#pragma unroll
        for (int ai = 0; ai < 2; ++ai)
#pragma unroll
            for (int m = 0; m < 4; ++m) {
                const int row = row0 + ai * HALF + m * 16;
#pragma unroll
                for (int bj = 0; bj < 2; ++bj) {
                    const int col = col0 + bj * HALF;
                    f32x4 v0 = acc[ai][bj][m][0], v1 = acc[ai][bj][m][1];
                    if constexpr (MODE == 4) {
                        const float* gp = gate + (row >= 8192 ? 6144 : 0) + col;
                        const f32x4 g0 = *(const f32x4*)gp, g1 = *(const f32x4*)(gp + 4);
                        const float* xp = X0 + (size_t)row * ld + col;
                        const f32x4 x0 = *(const f32x4*)xp, x1 = *(const f32x4*)(xp + 4);
                        float* op = OF + (size_t)row * ld + col;
                        *(f32x4*)op = x0 + g0 * v0; *(f32x4*)(op + 4) = x1 + g1 * v1;
                    } else {
                        if constexpr (MODE == 1) {
#pragma unroll
                            for (int e = 0; e < 4; ++e) { v0[e] = 1.f / (1.f + __expf(-v0[e])); v1[e] = 1.f / (1.f + __expf(-v1[e])); }
                        }
                        if constexpr (MODE == 5) {
#pragma unroll
                            for (int e = 0; e < 4; ++e) { float a = fmaxf(v0[e], 0.f), b = fmaxf(v1[e], 0.f); v0[e] = a * a; v1[e] = b * b; }
                        }
                        if constexpr (MODE == 3) {
                            const u32x4 gs = *(const u32x4*)(G + (size_t)row * 2048 + col);
                            const u32x4 gq = *(const u32x4*)(G + (size_t)row * 2048 + 1024 + col);
                            const u32x4 yp = *(const u32x4*)(YP + (size_t)row * 1024 + col);
#pragma unroll
                            for (int e = 0; e < 2; ++e) {
                                v0[2 * e] = __builtin_bit_cast(float, gs[e] << 16) * v0[2 * e] + __builtin_bit_cast(float, gq[e] << 16) * __builtin_bit_cast(float, yp[e] << 16);
                                v0[2 * e + 1] = __builtin_bit_cast(float, gs[e] & 0xffff0000u) * v0[2 * e + 1] + __builtin_bit_cast(float, gq[e] & 0xffff0000u) * __builtin_bit_cast(float, yp[e] & 0xffff0000u);
                                v1[2 * e] = __builtin_bit_cast(float, gs[2 + e] << 16) * v1[2 * e] + __builtin_bit_cast(float, gq[2 + e] << 16) * __builtin_bit_cast(float, yp[2 + e] << 16);
                                v1[2 * e + 1] = __builtin_bit_cast(float, gs[2 + e] & 0xffff0000u) * v1[2 * e + 1] + __builtin_bit_cast(float, gq[2 + e] & 0xffff0000u) * __builtin_bit_cast(float, yp[2 + e] & 0xffff0000u);
                            }
                        }
                        u32x4 w; w.x = cvt_pk_bf16(v0[0], v0[1]); w.y = cvt_pk_bf16(v0[2], v0[3]); w.z = cvt_pk_bf16(v1[0], v1[1]); w.w = cvt_pk_bf16(v1[2], v1[3]);
                        *(u32x4*)(base + (size_t)row * ld + col) = w;
                        if constexpr (MODE == 0) {
                            if (dohalo && (row & 127) >= 125) *(u32x4*)(halo + ((size_t)(row >> 7) * 3 + ((row & 127) - 125)) * 3072 + col) = w;
                        }
                    }
                }
            }
    }
};


template <class Epi, class Sched, bool ALIGN_EPI = false, bool SP2 = false>
__device__ __forceinline__ void gemm_phase(PG8_LAS unsigned char* lds, const Gemm g, const Sched& S, const Epi& E) {
    const int tid = threadIdx.x, wid = __builtin_amdgcn_readfirstlane(tid >> 6), lane = tid & 63, wr = wid >> 2, wc = wid & 3, fr = lane & 15, fq = lane >> 4;
    const int K = g.K, nt = K / BK;
    unsigned voffA[2], voffB[2];
#pragma unroll
    for (int i = 0; i < 2; ++i) { int R, C; stage_rc(tid * 16 + i * 8192, R, C); const int Rb = Epi::PERM ? ((R & ~31) + perm32(R & 31)) : R;
        voffA[i] = (unsigned)(R * K + C) * 2u; voffB[i] = (unsigned)(Rb * K + C) * 2u; }
    const size_t kstep = (size_t)(BK * 2);
    const size_t hstep = (size_t)HALF * K * 2;
    const size_t tstep = 2 * hstep;
    const unsigned ldsw = (unsigned)wid * 1024u;
    const int aoff = lds_byte(wr * 64 + fr, fq * 8), boff = lds_byte(wc * 32 + fr, fq * 8);
#define PG8_SA(b, h) (((b) * 2 + (h)) * HTB)
#define PG8_SB(b, h) ((4 + (b) * 2 + (h)) * HTB)
#define PG8_STAGE(bufoff, gbase, voff) do { _Pragma("unroll") for (int _i = 0; _i < 2; ++_i) \
        __builtin_amdgcn_global_load_lds((const unsigned*)((const char*)(gbase) + (voff)[_i]), (PG8_LAS unsigned*)(lds + (bufoff) + ldsw + _i * 8192), 16, 0, 0); } while (0)
#define PG8_LDA(dst, b, h) do { _Pragma("unroll") for (int m = 0; m < 4; ++m) _Pragma("unroll") for (int k = 0; k < 2; ++k) dst[m][k] = *(const PG8_LAS bf16x8*)(lds + PG8_SA(b, h) + aoff + m * 2048 + k * 1024); } while (0)
#define PG8_LDB(dst, b, h) do { _Pragma("unroll") for (int n = 0; n < 2; ++n) _Pragma("unroll") for (int k = 0; k < 2; ++k) dst[n][k] = *(const PG8_LAS bf16x8*)(lds + PG8_SB(b, h) + boff + n * 2048 + k * 1024); } while (0)
#define PG8_MMA(ai, bj, At, Bt) do { __builtin_amdgcn_s_setprio(1); _Pragma("unroll") for (int m = 0; m < 4; ++m) _Pragma("unroll") for (int n = 0; n < 2; ++n) _Pragma("unroll") for (int k = 0; k < 2; ++k) \
        acc[ai][bj][m][n] = __builtin_amdgcn_mfma_f32_16x16x32_bf16(Bt[n][k], At[m][k], acc[ai][bj][m][n], 0, 0, 0); __builtin_amdgcn_s_setprio(0); } while (0)
#define PG8_WAIT_V(n) asm volatile("s_waitcnt vmcnt(" #n ")" ::: "memory")
#define PG8_WAIT_L(n) asm volatile("s_waitcnt lgkmcnt(" #n ")" ::: "memory")
#define PG8_BAR __builtin_amdgcn_s_barrier()
#define PG8_SCHED __builtin_amdgcn_sched_barrier(0)
    Unit cur, nxt; int ui = 0;
    if (!S.next(0, cur)) return;
    f32x4 acc[2][2][4][2];
#pragma unroll
    for (int a = 0; a < 2; ++a)
#pragma unroll
        for (int b = 0; b < 2; ++b)
#pragma unroll
            for (int m = 0; m < 4; ++m)
#pragma unroll
                for (int n = 0; n < 2; ++n) acc[a][b][m][n] = (f32x4){0.f, 0.f, 0.f, 0.f};
    bf16x8 At[4][2], B0[2][2], B1[2][2];
    const char* cA = (const char*)g.A + (size_t)cur.pm * tstep; const char* cB = (const char*)g.Bt + (size_t)cur.pn * tstep;
    S.a_ready(cur);
    if constexpr (SP2) {
        PG8_STAGE(PG8_SB(0, 0), cB, voffB); PG8_STAGE(PG8_SB(0, 1), cB + hstep, voffB); PG8_STAGE(PG8_SA(0, 0), cA, voffA); PG8_STAGE(PG8_SA(0, 1), cA + hstep, voffA);
        if (wr == 1) PG8_BAR;
        PG8_WAIT_V(2); PG8_BAR;
        PG8_STAGE(PG8_SB(1, 0), cB + kstep, voffB); PG8_STAGE(PG8_SA(1, 0), cA + kstep, voffA); PG8_STAGE(PG8_SB(1, 1), cB + hstep + kstep, voffB);
        PG8_WAIT_V(6); PG8_BAR;
    } else {
        PG8_STAGE(PG8_SB(0, 0), cB, voffB); PG8_STAGE(PG8_SA(0, 0), cA, voffA); PG8_STAGE(PG8_SB(0, 1), cB + hstep, voffB); PG8_STAGE(PG8_SA(0, 1), cA + hstep, voffA);
        if (wr == 1) PG8_BAR;
        PG8_WAIT_V(4); PG8_BAR;
        PG8_STAGE(PG8_SB(1, 0), cB + kstep, voffB); PG8_STAGE(PG8_SA(1, 0), cA + kstep, voffA); PG8_STAGE(PG8_SB(1, 1), cB + hstep + kstep, voffB);
        PG8_WAIT_V(6); PG8_BAR;
    }
    for (;;) {
        const bool has_next = S.next(ui + 1, nxt);
        const char* nA = has_next ? (const char*)g.A + (size_t)nxt.pm * tstep : cA; const char* nB = has_next ? (const char*)g.Bt + (size_t)nxt.pn * tstep : cB;
        for (int t = 0; t < nt; t += 2) {
            const bool last = (t == nt - 2);
            const char* a1 = cA + (size_t)(t + 1) * kstep;
            const char* a2 = last ? nA : cA + (size_t)(t + 2) * kstep; const char* b2 = last ? nB : cB + (size_t)(t + 2) * kstep;
            const char* a3 = a2 + kstep; const char* b3 = b2 + kstep;
            if (last && has_next) S.a_ready(nxt);
            if constexpr (SP2) {
            PG8_LDB(B0, 0, 0); PG8_LDB(B1, 0, 1); PG8_SCHED; PG8_LDA(At, 0, 0); PG8_STAGE(PG8_SA(1, 1), a1 + hstep, voffA);
            PG8_WAIT_V(8); PG8_WAIT_L(0); PG8_BAR; PG8_MMA(0, 0, At, B0); PG8_MMA(0, 1, At, B1); PG8_BAR; PG8_SCHED;
            PG8_LDA(At, 0, 1); PG8_STAGE(PG8_SB(0, 0), b2, voffB); PG8_STAGE(PG8_SB(0, 1), b2 + hstep, voffB); PG8_STAGE(PG8_SA(0, 0), a2, voffA);
            PG8_WAIT_V(8); PG8_WAIT_L(0); PG8_BAR; PG8_MMA(1, 0, At, B0); PG8_MMA(1, 1, At, B1); PG8_BAR; PG8_SCHED;
            PG8_LDB(B0, 1, 0); PG8_LDB(B1, 1, 1); PG8_SCHED; PG8_LDA(At, 1, 0); PG8_STAGE(PG8_SA(0, 1), a2 + hstep, voffA);
            PG8_WAIT_V(8); PG8_WAIT_L(0); PG8_BAR; PG8_MMA(0, 0, At, B0); PG8_MMA(0, 1, At, B1); PG8_BAR; PG8_SCHED;
            PG8_LDA(At, 1, 1); PG8_STAGE(PG8_SB(1, 0), b3, voffB); PG8_STAGE(PG8_SB(1, 1), b3 + hstep, voffB); PG8_STAGE(PG8_SA(1, 0), a3, voffA);
            PG8_WAIT_V(8); PG8_WAIT_L(0); PG8_BAR; PG8_MMA(1, 0, At, B0); PG8_MMA(1, 1, At, B1); PG8_BAR; PG8_SCHED;
            } else {
            PG8_LDB(B0, 0, 0); PG8_SCHED; PG8_LDA(At, 0, 0); PG8_STAGE(PG8_SA(1, 1), a1 + hstep, voffA);
            PG8_WAIT_L(8); PG8_BAR; PG8_WAIT_L(0); PG8_MMA(0, 0, At, B0); PG8_BAR; PG8_SCHED;
            PG8_LDB(B1, 0, 1); PG8_STAGE(PG8_SB(0, 0), b2, voffB);
            PG8_BAR; PG8_WAIT_L(0); PG8_MMA(0, 1, At, B1); PG8_BAR;
            PG8_LDA(At, 0, 1); PG8_STAGE(PG8_SA(0, 0), a2, voffA);
            PG8_BAR; PG8_WAIT_L(0); PG8_MMA(1, 0, At, B0); PG8_BAR; PG8_SCHED;
            PG8_STAGE(PG8_SB(0, 1), b2 + hstep, voffB);
            PG8_WAIT_V(6); PG8_BAR; PG8_MMA(1, 1, At, B1); PG8_BAR;
            PG8_LDB(B0, 1, 0); PG8_SCHED; PG8_LDA(At, 1, 0); PG8_STAGE(PG8_SA(0, 1), a2 + hstep, voffA);
            PG8_WAIT_L(8); PG8_BAR; PG8_WAIT_L(0); PG8_MMA(0, 0, At, B0); PG8_BAR; PG8_SCHED;
            PG8_LDB(B1, 1, 1); PG8_STAGE(PG8_SB(1, 0), b3, voffB);
            PG8_BAR; PG8_WAIT_L(0); PG8_MMA(0, 1, At, B1); PG8_BAR;
            PG8_LDA(At, 1, 1); PG8_STAGE(PG8_SA(1, 0), a3, voffA);
            PG8_BAR; PG8_WAIT_L(0); PG8_MMA(1, 0, At, B0); PG8_BAR; PG8_SCHED;
            PG8_STAGE(PG8_SB(1, 1), b3 + hstep, voffB);
            PG8_WAIT_V(6); PG8_BAR; PG8_MMA(1, 1, At, B1); PG8_BAR;
            }
        }
        if constexpr (ALIGN_EPI) { if (wr == 0) PG8_BAR; }
        if constexpr (!Epi::AFTER_DRAIN) { E(acc, cur, wr, wc, fr, fq); S.done(cur); }
        if (!has_next) break;
#pragma unroll
        for (int a = 0; a < 2; ++a)
#pragma unroll
            for (int b = 0; b < 2; ++b)
#pragma unroll
                for (int m = 0; m < 4; ++m)
#pragma unroll
                    for (int n = 0; n < 2; ++n) acc[a][b][m][n] = (f32x4){0.f, 0.f, 0.f, 0.f};
        cur = nxt; cA = nA; cB = nB; ++ui;
        if constexpr (ALIGN_EPI) { if (wr == 1) PG8_BAR; }
    }
    PG8_WAIT_V(0);
    if constexpr (!ALIGN_EPI) { if (wr == 0) PG8_BAR; }
    PG8_BAR;
    if constexpr (Epi::AFTER_DRAIN) { E.fused(acc, cur, wr, wc, fr, fq, lds, wid, lane); S.done(cur); }
#undef PG8_SA
#undef PG8_SB
#undef PG8_STAGE
#undef PG8_LDA
#undef PG8_LDB
#undef PG8_MMA
#undef PG8_WAIT_V
#undef PG8_WAIT_L
#undef PG8_BAR
#undef PG8_SCHED
}
}
#define LAS __attribute__((address_space(3)))
typedef unsigned short bf16;
typedef unsigned v4u __attribute__((ext_vector_type(4)));
typedef unsigned v2u __attribute__((ext_vector_type(2)));
typedef float f32x4 __attribute__((ext_vector_type(4)));
typedef short bf16x8 __attribute__((ext_vector_type(8)));
typedef short s16x4 __attribute__((ext_vector_type(4)));
typedef short v4i16_t __attribute__((ext_vector_type(4)));

constexpr int T = 16384, SEQ = 8192, D = 1024, DI = 2048, XW = 3072, FF = 4096, NH = 32, NMOD = 6144, INC = 8224;
constexpr float EPS = 1e-5f;
constexpr size_t MiB = 1u << 20;
constexpr size_t WS_WIN = 0, WS_WBSSD = 16 * MiB, WS_WPP = 20 * MiB, WS_WOUT = 22 * MiB, WS_WDT = 24 * MiB, WS_MOD = 24 * MiB + 65536;
constexpr size_t WS_DT = 25 * MiB, WS_ACS = 27 * MiB, WS_HALO = 29 * MiB;
constexpr size_t WS_XBC = 32 * MiB, WS_GATES = 32 * MiB, WS_UP = 32 * MiB;
constexpr size_t WS_H = 128 * MiB, WS_MERGED = 128 * MiB;
constexpr size_t WS_UPOOL = 160 * MiB, WS_YPOOL = 160 * MiB, WS_H2 = 160 * MiB;
constexpr size_t WS_POOLED = 192 * MiB, WS_STATES = 192 * MiB, WS_WUP = 192 * MiB, WS_WDOWN = 200 * MiB;
constexpr int LDS_BYTES = 147456;

typedef float f32x2_t __attribute__((ext_vector_type(2))); typedef __bf16 bf16x2_t __attribute__((ext_vector_type(2)));
__device__ __forceinline__ unsigned pk2(float lo, float hi) { f32x2_t v = {lo, hi}; bf16x2_t b = __builtin_convertvector(v, bf16x2_t); return __builtin_bit_cast(unsigned, b); }
__device__ __forceinline__ float bflo(unsigned u) { return __builtin_bit_cast(float, u << 16); }
__device__ __forceinline__ float bfhi(unsigned u) { return __builtin_bit_cast(float, u & 0xffff0000u); }
__device__ __forceinline__ float wave_sum(float v) {
#pragma unroll
    for (int o = 1; o < 64; o <<= 1) v += __shfl_xor(v, o);
    return v;
}
__device__ __forceinline__ float siluf(float v) { return v / (1.f + __expf(-v)); }
__device__ __forceinline__ s16x4 ds_tr(const unsigned char* p) { return __builtin_bit_cast(s16x4, __builtin_amdgcn_ds_read_tr16_b64_v4i16((LAS v4i16_t*)p)); }
__device__ __forceinline__ bf16x8 cat8(s16x4 a, s16x4 b) { return __builtin_shufflevector(a, b, 0, 1, 2, 3, 4, 5, 6, 7); }
#define MFMA16(a, b, c) __builtin_amdgcn_mfma_f32_16x16x32_bf16((a), (b), (c), 0, 0, 0)

__device__ __forceinline__ void transpose_item(const float* W, int ldw, int k0, int c0, bf16* WT, int K, int drow0, LAS float* scr, int lane) {
#pragma unroll 8
    for (int i = 0; i < 32; ++i) { const int kk = 2 * i + (lane >> 5); scr[kk * 33 + (lane & 31)] = W[(size_t)(k0 + kk) * ldw + c0 + (lane & 31)]; }
    asm volatile("s_waitcnt lgkmcnt(0)" ::: "memory");
    const int c = lane & 7;
#pragma unroll
    for (int j = 0; j < 4; ++j) { const int n = (lane >> 3) + 8 * j; const LAS float* s = scr + (8 * c) * 33 + n;
        v4u o; o.x = pk2(s[0 * 33], s[1 * 33]); o.y = pk2(s[2 * 33], s[3 * 33]); o.z = pk2(s[4 * 33], s[5 * 33]); o.w = pk2(s[6 * 33], s[7 * 33]);
        *(v4u*)(WT + (size_t)(drow0 + n) * K + k0 + 8 * c) = o; }
    asm volatile("s_waitcnt lgkmcnt(0)" ::: "memory");
}

__device__ __forceinline__ void norm_mod_row(const float* xrow, const float* w, const float* scale, const float* shift, bf16* orow, int lane) {
    const f32x4* xr = (const f32x4*)xrow + lane;
    f32x4 v[4]; float s = 0.f;
#pragma unroll
    for (int j = 0; j < 4; ++j) { v[j] = xr[64 * j]; s += (v[j].x * v[j].x + v[j].y * v[j].y) + (v[j].z * v[j].z + v[j].w * v[j].w); }
    const float rstd = rsqrtf(wave_sum(s) * (1.f / D) + EPS);
    v2u* o8 = (v2u*)orow + lane;
#pragma unroll
    for (int j = 0; j < 4; ++j) {
        const f32x4 ww = ((const f32x4*)w)[lane + 64 * j], sc = ((const f32x4*)scale)[lane + 64 * j], sh = ((const f32x4*)shift)[lane + 64 * j];
        f32x4 r = v[j] * rstd * ww * (sc + 1.f) + sh;
        v2u o; o.x = pk2(r.x, r.y); o.y = pk2(r.z, r.w); o8[64 * j] = o;
    }
}

#define XB_TMO      128
#define XB_XCNT(j)  (256  + 64 * (j))
#define XB_XSUB(j)  (1280 + 64 * (j))
#define XB_XGEN(j)  (2304 + 64 * (j))
#define XB_TOP      3328
#define XB_TOPGEN   3392
#define XCD_BAR_WORDS 3456
#define XB_SPIN_CAP (1u << 18)

__device__ __forceinline__ unsigned xb_ld(unsigned* p)              { return __hip_atomic_load(p, __ATOMIC_RELAXED, __HIP_MEMORY_SCOPE_AGENT); }
__device__ __forceinline__ unsigned xb_add(unsigned* p, unsigned v) { return __hip_atomic_fetch_add(p, v, __ATOMIC_RELAXED, __HIP_MEMORY_SCOPE_AGENT); }
__device__ __forceinline__ unsigned xb_xcc_id() { return (unsigned)__builtin_amdgcn_s_getreg((3 << 11) | 20) & 0xFu; }
#define XB_SPIN(cond, bar) do { unsigned _sp = 0; while (cond) { __builtin_amdgcn_s_sleep(1); \
    if ((++_sp & 255u) == 0u) { if (xb_ld(&(bar)[XB_TMO])) break; if (_sp > XB_SPIN_CAP) { atomicAdd(&(bar)[XB_TMO], 1u); break; } } } } while (0)

struct XcdBarrier {
    unsigned* bar; unsigned x;
    volatile LAS unsigned* st;
};

__device__ __forceinline__ XcdBarrier xcd_barrier_post(unsigned* bar, volatile LAS unsigned* st) {
    XcdBarrier b; b.bar = bar; b.x = xb_xcc_id(); b.st = st;
    if (threadIdx.x == 0) (void)xb_add(&bar[XB_XCNT(b.x)], 1u);
    return b;
}
__device__ __forceinline__ void xcd_barrier_complete(unsigned* bar, unsigned x, unsigned& nloc, unsigned& nx) {
    const unsigned G = gridDim.x * gridDim.y * gridDim.z;
    unsigned sum, cnt, mine, sp = 0u;
    for (;;) {
        sum = 0u; cnt = 0u; mine = 0u;
#pragma unroll
        for (unsigned j = 0; j < 16; ++j) { const unsigned c = xb_ld(&bar[XB_XCNT(j)]); sum += c; cnt += (c > 0u) ? 1u : 0u; mine = (j == x) ? c : mine; }
        if (sum == G) break;
        __builtin_amdgcn_s_sleep(1);
        if ((++sp & 255u) == 0u) { if (xb_ld(&bar[XB_TMO])) break; if (sp > XB_SPIN_CAP) { atomicAdd(&bar[XB_TMO], 1u); break; } }
    }
    nloc = mine > 0u ? mine : 1u; nx = cnt > 0u ? cnt : 1u;
}

__device__ __forceinline__ void xcd_barrier(const XcdBarrier& b) {
    asm volatile("s_waitcnt vmcnt(0)" ::: "memory");
    __syncthreads();
    if (threadIdx.x == 0) {
        unsigned* bar = b.bar;
        __builtin_amdgcn_s_waitcnt(0);
        unsigned nloc = b.st[0], nx = b.st[1];
        if (nloc == 0u) { xcd_barrier_complete(bar, b.x, nloc, nx); b.st[0] = nloc; b.st[1] = nx; }
        const unsigned old = xb_add(&bar[XB_XSUB(b.x)], 1u);
        const unsigned gen = old / nloc;
        if (old + 1u == (gen + 1u) * nloc) {
            __builtin_amdgcn_fence(__ATOMIC_RELEASE, "agent");
            asm volatile("s_waitcnt vmcnt(0)" ::: "memory");
            const unsigned og = xb_add(&bar[XB_TOP], 1u);
            const unsigned tg = og / nx;
            if (og + 1u == (tg + 1u) * nx) xb_add(&bar[XB_TOPGEN], 1u);
            else XB_SPIN(xb_ld(&bar[XB_TOPGEN]) == tg, bar);
            __builtin_amdgcn_fence(__ATOMIC_ACQUIRE, "agent");
            xb_add(&bar[XB_XGEN(b.x)], 1u);
            asm volatile("s_waitcnt vmcnt(0)" ::: "memory");
        } else {
            XB_SPIN(xb_ld(&bar[XB_XGEN(b.x)]) == gen, bar);
            __builtin_amdgcn_fence(__ATOMIC_ACQUIRE, "agent");
            asm volatile("s_waitcnt vmcnt(0)" ::: "memory");
        }
    }
    __syncthreads();
}

constexpr size_t WS_BAR = 24 * MiB + 131072;
struct Params { const float* in[21]; float* out; unsigned char* ws; };

__global__ void __launch_bounds__(512, 2) mk_fwd(Params P) {
    extern __shared__ __attribute__((aligned(16))) unsigned char lds[];
    cg::grid_group grid = cg::this_grid();
#define PHASE_IDS int tid = threadIdx.x; asm volatile("" : "+v"(tid)); const int lane = tid & 63, wave = __builtin_amdgcn_readfirstlane(tid >> 6), gw = blockIdx.x * 8 + wave; (void)lane; (void)wave; (void)gw;
    const int G = gridDim.x, NGW = G * 8;
    unsigned char* ws = P.ws;
    const float* x = P.in[0]; const float* cvec = P.in[1]; const float* w_ada = P.in[2]; const float* b_ada = P.in[3]; const float* norm_mix_w = P.in[4];
    const float* w_in = P.in[5]; const float* conv_w = P.in[6]; const float* conv_b = P.in[7]; const float* dt_bias = P.in[8]; const float* a_log = P.in[9];
    const float* d_skip = P.in[10]; const float* ssd_norm_w = P.in[11]; const float* w_bssd = P.in[12]; const float* pool_w = P.in[13]; const float* pool_scale = P.in[14];
    const float* w_bpool = P.in[15]; const float* w_out = P.in[16]; const float* norm_mlp_w = P.in[17]; const float* w_up = P.in[18]; const float* w_down = P.in[19];
    const float* norm_final_w = P.in[20];
    bf16* Win_t = (bf16*)(ws + WS_WIN); bf16* Wbssd_t = (bf16*)(ws + WS_WBSSD); bf16* Wpp_t = (bf16*)(ws + WS_WPP); bf16* Wout_t = (bf16*)(ws + WS_WOUT);
    bf16* Wdt_t = (bf16*)(ws + WS_WDT); float* MOD = (float*)(ws + WS_MOD); float* DT = (float*)(ws + WS_DT); float* ACS = (float*)(ws + WS_ACS);
    bf16* HALO = (bf16*)(ws + WS_HALO); bf16* XBC = (bf16*)(ws + WS_XBC); bf16* GATES = (bf16*)(ws + WS_GATES); bf16* UPB = (bf16*)(ws + WS_UP);
    bf16* H = (bf16*)(ws + WS_H); bf16* MERGED = (bf16*)(ws + WS_MERGED); bf16* UPOOL = (bf16*)(ws + WS_UPOOL); bf16* YPOOL = (bf16*)(ws + WS_YPOOL);
    bf16* H2 = (bf16*)(ws + WS_H2); bf16* POOLED = (bf16*)(ws + WS_POOLED); bf16* STATES = (bf16*)(ws + WS_STATES); bf16* Wup_t = (bf16*)(ws + WS_WUP);
    bf16* Wdown_t = (bf16*)(ws + WS_WDOWN);
    bf16* Z = (bf16*)P.out;
    float* X1 = P.out;
    LAS unsigned char* gl = (LAS unsigned char*)lds;
    volatile LAS unsigned* xst = (volatile LAS unsigned*)(gl + 131072);
    if (threadIdx.x < 4) xst[threadIdx.x] = 0u;
    __syncthreads();
    const XcdBarrier xbar = xcd_barrier_post((unsigned*)(P.ws + WS_BAR), xst);
    if (P.ws == nullptr) grid.sync();
#ifdef TPROBE
    unsigned long long* TS = (unsigned long long*)(ws + 24 * MiB + 131072);
#define STAMP(k) do { if (blockIdx.x == 0 && threadIdx.x == 0) TS[k] = __builtin_amdgcn_s_memrealtime(); } while (0)
#else
#define STAMP(k) do {} while (0)
#endif
    STAMP(0);

    REP(0)
    {
        PHASE_IDS
        LAS float* red = (LAS float*)gl;
        for (int it = blockIdx.x; it < 96; it += G) {
            const int j = it * 64 + lane; float a0 = 0.f, a1 = 0.f;
#pragma unroll 8
            for (int k = wave * 128; k < wave * 128 + 128; ++k) { const float w = w_ada[(size_t)k * NMOD + j]; a0 += siluf(cvec[k]) * w; a1 += siluf(cvec[1024 + k]) * w; }
            red[wave * 128 + lane] = a0; red[wave * 128 + 64 + lane] = a1; __syncthreads();
            if (tid < 128) { float s = 0.f;
#pragma unroll
                for (int q = 0; q < 8; ++q) s += red[q * 128 + tid];
                const int jj = it * 64 + (tid & 63); MOD[(tid >> 6) * NMOD + jj] = s + b_ada[jj]; }
            __syncthreads();
        }
        LAS float* scr = (LAS float*)(gl + wave * 16384);
        constexpr int I_IN = 16 * 257, I_BS = 32 * 32, I_O = 16 * 32;
        for (int it = gw; it < I_IN + I_BS + I_O; it += NGW) {
            int r = it;
            if (r < I_IN) { const int kb = r / 257, nb = r % 257; const int c0 = nb * 32;
                if (nb == 160) transpose_item(w_in, INC, kb * 64, c0, Wdt_t, D, 0, scr, lane);
                else transpose_item(w_in, INC, kb * 64, c0, Win_t, D, nb < 160 ? c0 : c0 - 32, scr, lane);
                continue; } r -= I_IN;
            if (r < I_BS) { transpose_item(w_bssd, D, (r / 32) * 64, (r % 32) * 32, Wbssd_t, DI, (r % 32) * 32, scr, lane); continue; } r -= I_BS;
            transpose_item(w_out, D, (r / 32) * 64, (r % 32) * 32, Wout_t, D, (r % 32) * 32, scr, lane);
        }
        for (int e = blockIdx.x * 512 + tid; e < D * D; e += G * 512) {
            const int n = e & 1023, k = e >> 10, g = k >> 8; const float* pw = pool_w + (size_t)k * 256; const float* ps = pool_scale + g * 256; const float* wb = w_bpool + (size_t)g * 256 * D + n;
            float a = 0.f;
#pragma unroll 8
            for (int j = 0; j < 256; ++j) a += pw[j] * ps[j] * wb[(size_t)j * D];
            Wpp_t[(size_t)n * D + k] = (bf16)(pk2(a, 0.f) & 0xffffu);
        }
    }
    xcd_barrier(xbar);
    STAMP(1);
    REP(1)
    { PHASE_IDS
    for (int m = gw; m < T; m += NGW) { const float* md = MOD + (m >> 13) * NMOD; norm_mod_row(x + (size_t)m * D, norm_mix_w, md + 1024, md, H + (size_t)m * D, lane); } }
    xcd_barrier(xbar);
    STAMP(2);
    REP(2)
    {
        PHASE_IDS
        pg8::Gemm g{H, Win_t, T, 6144, D}; pg8::StaticOrder S; S.init(T, 6144, G, (int)blockIdx.x);
        pg8::EpiMk<0> E{}; E.O0 = Z; E.O1 = XBC; E.O2 = UPOOL; E.halo = HALO; E.ldc = 0;
        pg8::gemm_phase<pg8::EpiMk<0>, pg8::StaticOrder, true, true>(gl, g, S, E);
        const int gq = lane >> 4, i = lane & 15;
        for (int it = gw; it < T / 16; it += NGW) {
            const int r0 = it * 16; f32x4 a0 = {0.f, 0.f, 0.f, 0.f}, a1 = {0.f, 0.f, 0.f, 0.f};
#pragma unroll 4
            for (int ks = 0; ks < 32; ++ks) {
                const bf16x8 af = *(const bf16x8*)(H + (size_t)(r0 + i) * D + 32 * ks + 8 * gq);
                const bf16x8 b0 = *(const bf16x8*)(Wdt_t + (size_t)i * D + 32 * ks + 8 * gq), b1 = *(const bf16x8*)(Wdt_t + (size_t)(16 + i) * D + 32 * ks + 8 * gq);
                a0 = MFMA16(af, b0, a0); a1 = MFMA16(af, b1, a1);
            }
#pragma unroll
            for (int r = 0; r < 4; ++r) { DT[(size_t)(r0 + 4 * gq + r) * NH + i] = a0[r]; DT[(size_t)(r0 + 4 * gq + r) * NH + 16 + i] = a1[r]; }
        }
    }
    xcd_barrier(xbar);
    STAMP(3);
    {
        PHASE_IDS
        const int tx = tid & 63, ty = tid >> 6;
        REP(30)
        for (int it = blockIdx.x; it < 768; it += G) {
            const int ch = it / 6, cb = it % 6; const int ch0 = cb * 512 + tx * 8; const size_t row0 = (size_t)ch * 128 + ty * 16;
            v4u raw[19];
#pragma unroll
            for (int r = 0; r < 16; ++r) raw[3 + r] = *(const v4u*)(XBC + (row0 + r) * XW + ch0);
            if (ty > 0) {
#pragma unroll
                for (int r = 0; r < 3; ++r) raw[r] = *(const v4u*)(XBC + (row0 - 3 + r) * XW + ch0);
            } else if ((ch & 63) != 0) {
#pragma unroll
                for (int r = 0; r < 3; ++r) raw[r] = *(const v4u*)(HALO + ((size_t)(ch - 1) * 3 + r) * XW + ch0);
            } else {
#pragma unroll
                for (int r = 0; r < 3; ++r) raw[r] = (v4u){0u, 0u, 0u, 0u};
            }
            asm volatile("s_waitcnt vmcnt(0)" ::: "memory"); __syncthreads();
            float wv[4][8], bv[8];
#pragma unroll
            for (int k = 0; k < 4; ++k) { const f32x4 a = *(const f32x4*)(conv_w + (size_t)k * XW + ch0), b = *(const f32x4*)(conv_w + (size_t)k * XW + ch0 + 4);
                wv[k][0] = a.x; wv[k][1] = a.y; wv[k][2] = a.z; wv[k][3] = a.w; wv[k][4] = b.x; wv[k][5] = b.y; wv[k][6] = b.z; wv[k][7] = b.w; }
            { const f32x4 a = *(const f32x4*)(conv_b + ch0), b = *(const f32x4*)(conv_b + ch0 + 4); bv[0] = a.x; bv[1] = a.y; bv[2] = a.z; bv[3] = a.w; bv[4] = b.x; bv[5] = b.y; bv[6] = b.z; bv[7] = b.w; }
#pragma unroll
            for (int r = 0; r < 16; ++r) {
                v4u o;
#pragma unroll
                for (int e = 0; e < 4; ++e) {
                    float lo = bv[2 * e], hi = bv[2 * e + 1];
#pragma unroll
                    for (int k = 0; k < 4; ++k) { const unsigned u = raw[r + k][e]; lo += wv[k][2 * e] * bflo(u); hi += wv[k][2 * e + 1] * bfhi(u); }
                    o[e] = pk2(siluf(lo), siluf(hi));
                }
                *(v4u*)((DRY(30) ? STATES + 16777216 + (((row0 + r) * XW) & 0xFFFFFF) : XBC + (row0 + r) * XW) + ch0) = o;
            }
        }
        REP(31)
        for (int e = blockIdx.x * 512 + tid; e < T * 128; e += G * 512) {
            const int t = e >> 7, c8 = (e & 127) * 8, gi = c8 >> 8, win = 2 << gi, pos = t & (SEQ - 1); const int cnt = (pos + 1 < win) ? pos + 1 : win;
            float s[8], u0[8];
#pragma unroll
            for (int q = 0; q < 8; ++q) s[q] = 0.f;
            for (int j = 0; j < cnt; ++j) { const v4u v = *(const v4u*)(UPOOL + (size_t)(t - j) * D + c8);
#pragma unroll
                for (int q = 0; q < 4; ++q) { const float lo = bflo(v[q]), hi = bfhi(v[q]); s[2 * q] += lo; s[2 * q + 1] += hi; if (j == 0) { u0[2 * q] = lo; u0[2 * q + 1] = hi; } } }
            const float inv = 1.f / (float)cnt; v4u o;
#pragma unroll
            for (int q = 0; q < 4; ++q) o[q] = pk2(s[2 * q] * inv - u0[2 * q], s[2 * q + 1] * inv - u0[2 * q + 1]);
            *(v4u*)(POOLED + (size_t)t * D + c8) = o;
        }
        for (int it = gw; it < 128 * NH; it += NGW) {
            const int ch = it >> 5, h = it & 31; const size_t r0 = (size_t)ch * 128 + 2 * lane; const float bias = dt_bias[h], A = -__expf(a_log[h]);
            float v0 = DT[r0 * NH + h] + bias, v1 = DT[(r0 + 1) * NH + h] + bias;
            const float d0 = v0 > 20.f ? v0 : log1pf(__expf(v0)), d1 = v1 > 20.f ? v1 : log1pf(__expf(v1));
            const float a0 = d0 * A, a1 = d1 * A; float incl = a0 + a1;
#pragma unroll
            for (int o = 1; o < 64; o <<= 1) { const float n = __shfl_up(incl, o); if (lane >= o) incl += n; }
            const float excl = incl - (a0 + a1);
            DT[r0 * NH + h] = d0; DT[(r0 + 1) * NH + h] = d1; ACS[r0 * NH + h] = excl + a0; ACS[(r0 + 1) * NH + h] = excl + a0 + a1;
        }
    }
    xcd_barrier(xbar);
    STAMP(4);
    REP(35)
    {
        pg8::Gemm g{POOLED, Wpp_t, T, D, D}; pg8::StaticOrder S; S.init(T, D, G, (int)blockIdx.x);
        pg8::EpiMk<2> E{}; E.O0 = YPOOL; E.ldc = D;
        pg8::gemm_phase<pg8::EpiMk<2>, pg8::StaticOrder, true, true>(gl, g, S, E);
    }

    xcd_barrier(xbar);
    STAMP(5);
    REP(4)
    {
        PHASE_IDS
        const int gq = lane >> 4, li = lane & 15, lr = li >> 2, lc = li & 3;
        unsigned char* ldsB = lds; unsigned char* ldsX = lds + 34816;
        for (int it = blockIdx.x; it < 512; it += G) {
            const int bc = it >> 2, g = it & 3; const size_t row0 = (size_t)bc * 128;
            for (int q = tid; q < 2048; q += 512) { const int r = q >> 4, c16 = q & 15; *(v4u*)(ldsB + r * 272 + c16 * 16) = *(const v4u*)(XBC + (row0 + r) * XW + 2048 + g * 128 + c16 * 8); }
            __syncthreads();
            bf16x8 Af[4];
#pragma unroll
            for (int ks = 0; ks < 4; ++ks) Af[ks] = cat8(ds_tr(ldsB + (32 * ks + 8 * gq + lr) * 272 + (16 * wave + 4 * lc) * 2), ds_tr(ldsB + (32 * ks + 8 * gq + 4 + lr) * 272 + (16 * wave + 4 * lc) * 2));
#pragma unroll 1
            for (int hh = 0; hh < 8; ++hh) {
                const int h = 8 * g + hh;
                { const int r = tid >> 2, qc = tid & 3;
                  const float sc = DT[(row0 + r) * NH + h] * __expf(ACS[(row0 + 127) * NH + h] - ACS[(row0 + r) * NH + h]);
#pragma unroll
                  for (int e = 0; e < 2; ++e) { const v4u v = *(const v4u*)(XBC + (row0 + r) * XW + h * 64 + qc * 16 + e * 8); v4u o;
#pragma unroll
                      for (int q = 0; q < 4; ++q) o[q] = pk2(bflo(v[q]) * sc, bfhi(v[q]) * sc);
                      *(v4u*)(ldsX + r * 144 + (qc * 16 + e * 8) * 2) = o; } }
                __syncthreads();
                f32x4 acc[4];
#pragma unroll
                for (int pt = 0; pt < 4; ++pt) acc[pt] = (f32x4){0.f, 0.f, 0.f, 0.f};
#pragma unroll
                for (int ks = 0; ks < 4; ++ks)
#pragma unroll
                    for (int pt = 0; pt < 4; ++pt) {
                        const bf16x8 bx = cat8(ds_tr(ldsX + (32 * ks + 8 * gq + lr) * 144 + (16 * pt + 4 * lc) * 2), ds_tr(ldsX + (32 * ks + 8 * gq + 4 + lr) * 144 + (16 * pt + 4 * lc) * 2));
                        acc[pt] = MFMA16(Af[ks], bx, acc[pt]);
                    }
                bf16* st = STATES + ((size_t)bc * NH + h) * 8192;
#pragma unroll
                for (int pt = 0; pt < 4; ++pt) { v2u o; o.x = pk2(acc[pt][0], acc[pt][1]); o.y = pk2(acc[pt][2], acc[pt][3]); *(v2u*)(st + (16 * pt + li) * 128 + 16 * wave + 4 * gq) = o; }
                __syncthreads();
            }
        }
    }
    xcd_barrier(xbar);
    STAMP(6);
    REP(5)
    { PHASE_IDS
    for (int e = blockIdx.x * 512 + tid; e < 131072; e += G * 512) {
        const int n4 = e & 31, p = (e >> 5) & 63, h = (e >> 11) & 31, b = e >> 16;
        float s0 = 0.f, s1 = 0.f, s2 = 0.f, s3 = 0.f;
#pragma unroll 8
        for (int c = 0; c < 64; ++c) {
            v2u* ptr = (v2u*)(STATES + (((size_t)(b * 64 + c) * NH + h) * 64 + p) * 128 + n4 * 4);
            const v2u v = *ptr; const float d = __expf(ACS[((size_t)b * SEQ + c * 128 + 127) * NH + h]);
            v2u o; o.x = pk2(s0, s1); o.y = pk2(s2, s3); *(DRY(5) ? (v2u*)(HALO) + (((size_t)c * 131072 + e) & 0x3FFFF) : ptr) = o;
            s0 = s0 * d + bflo(v.x); s1 = s1 * d + bfhi(v.x); s2 = s2 * d + bflo(v.y); s3 = s3 * d + bfhi(v.y);
        }
    } }

    xcd_barrier(xbar);
    STAMP(7);
    REP(6)
    {
        PHASE_IDS
        const int gq = lane >> 4, li = lane & 15, lr = li >> 2, lc = li & 3;
        unsigned char* ldsC = lds; unsigned char* ldsB = lds + 34816; unsigned char* ldsX0 = lds + 69632; float* ldsA = (float*)(lds + 106496); float* ldsD = (float*)(lds + 110592);
        for (int it = blockIdx.x; it < 512; it += G) {
            const int bc = it >> 2, g = it & 3; const size_t row0 = (size_t)bc * 128;
            for (int q = tid; q < 2048; q += 512) { const int r = q >> 4, c16 = q & 15;
                *(v4u*)(ldsB + r * 272 + c16 * 16) = *(const v4u*)(XBC + (row0 + r) * XW + 2048 + g * 128 + c16 * 8);
                *(v4u*)(ldsC + r * 272 + c16 * 16) = *(const v4u*)(XBC + (row0 + r) * XW + 2560 + g * 128 + c16 * 8); }
            for (int q = tid; q < 1024; q += 512) { const int hh = q >> 7, r = q & 127; ldsA[q] = ACS[(row0 + r) * NH + 8 * g + hh]; ldsD[q] = DT[(row0 + r) * NH + 8 * g + hh]; }
            const int xr = tid >> 2, xq = tid & 3;
            { const bf16* src = XBC + (row0 + xr) * XW + (8 * g) * 64 + xq * 16; *(v4u*)(ldsX0 + xr * 144 + xq * 32) = *(const v4u*)src; *(v4u*)(ldsX0 + xr * 144 + xq * 32 + 16) = *(const v4u*)(src + 8); }
            __syncthreads();
            bf16x8 Cf[4];
#pragma unroll
            for (int ks = 0; ks < 4; ++ks) Cf[ks] = *(const bf16x8*)(ldsC + (16 * wave + li) * 272 + (32 * ks + 8 * gq) * 2);
            f32x4 sc[8];
#pragma unroll
            for (int st = 0; st < 8; ++st) { sc[st] = (f32x4){0.f, 0.f, 0.f, 0.f};
                if (st <= wave) {
#pragma unroll
                    for (int ks = 0; ks < 4; ++ks) { const bf16x8 af = *(const bf16x8*)(ldsB + (16 * st + li) * 272 + (32 * ks + 8 * gq) * 2); sc[st] = MFMA16(af, Cf[ks], sc[st]); }
                } }
            const int lrow = 16 * wave + li;
            float ssq = 0.f;
            bool dmask[4];
#pragma unroll
            for (int r = 0; r < 4; ++r) dmask[r] = (4 * gq + r <= li);
#pragma unroll 1
            for (int hh = 0; hh < 8; ++hh) {
                const int h = 8 * g + hh; unsigned char* ldsX = ldsX0 + (hh & 1) * 18432; unsigned char* ldsXn = ldsX0 + ((hh + 1) & 1) * 18432;
                const float* aA = ldsA + hh * 128; const float* aD = ldsD + hh * 128;
                v4u nx0 = {0u, 0u, 0u, 0u}, nx1 = {0u, 0u, 0u, 0u};
                if (hh < 7) { const bf16* src = XBC + (row0 + xr) * XW + (h + 1) * 64 + xq * 16; nx0 = *(const v4u*)src; nx1 = *(const v4u*)(src + 8); }
                const float al = aA[lrow];
                f32x4 acc[4];
                const bf16* prev = STATES + ((size_t)bc * NH + h) * 8192;
#pragma unroll
                for (int pt = 0; pt < 4; ++pt) { acc[pt] = (f32x4){0.f, 0.f, 0.f, 0.f};
#pragma unroll
                    for (int ks = 0; ks < 4; ++ks) { const bf16x8 ap = *(const bf16x8*)(prev + (16 * pt + li) * 128 + 32 * ks + 8 * gq); acc[pt] = MFMA16(ap, Cf[ks], acc[pt]); } }
                const float el = __expf(al);
#pragma unroll
                for (int pt = 0; pt < 4; ++pt) acc[pt] = acc[pt] * el;
#pragma unroll
                for (int q = 0; q < 4; ++q) {
                    if (2 * q <= wave) {
                        const f32x4 as0 = *(const f32x4*)(aA + 32 * q + 4 * gq), as1 = *(const f32x4*)(aA + 32 * q + 16 + 4 * gq);
                        const f32x4 dd0 = *(const f32x4*)(aD + 32 * q + 4 * gq), dd1 = *(const f32x4*)(aD + 32 * q + 16 + 4 * gq);
                        float mv[8];
#pragma unroll
                        for (int r = 0; r < 4; ++r) {
                            float v0 = sc[2 * q][r] * (__expf(fminf(al - as0[r], 0.f)) * dd0[r]);
                            float v1 = sc[2 * q + 1][r] * (__expf(fminf(al - as1[r], 0.f)) * dd1[r]);
                            if (2 * q == wave && !dmask[r]) v0 = 0.f;
                            if (2 * q + 1 == wave && !dmask[r]) v1 = 0.f;
                            mv[r] = v0; mv[4 + r] = v1;
                        }
                        v4u mp; mp.x = pk2(mv[0], mv[1]); mp.y = pk2(mv[2], mv[3]); mp.z = pk2(mv[4], mv[5]); mp.w = pk2(mv[6], mv[7]);
                        const bf16x8 Mf = __builtin_bit_cast(bf16x8, mp);
#pragma unroll
                        for (int pt = 0; pt < 4; ++pt) {
                            const bf16x8 ax = cat8(ds_tr(ldsX + (32 * q + 4 * gq + lr) * 144 + (16 * pt + 4 * lc) * 2), ds_tr(ldsX + (32 * q + 16 + 4 * gq + lr) * 144 + (16 * pt + 4 * lc) * 2));
                            acc[pt] = MFMA16(ax, Mf, acc[pt]);
                        }
                    }
                }
                const float Dh = d_skip[h];
#pragma unroll
                for (int pt = 0; pt < 4; ++pt) {
                    const int p0 = 16 * pt + 4 * gq;
                    const v2u xv = *(const v2u*)(ldsX + lrow * 144 + p0 * 2);
                    v2u* zp = (v2u*)(Z + (row0 + lrow) * DI + h * 64 + p0);
                    const v2u zv = *zp; if (DRY(6)) zp = (v2u*)(HALO + ((((row0 + lrow) * DI + h * 64 + p0)) & 0xFFFFC));
                    const float y0 = (acc[pt][0] + Dh * bflo(xv.x)) * siluf(bflo(zv.x)), y1 = (acc[pt][1] + Dh * bfhi(xv.x)) * siluf(bfhi(zv.x));
                    const float y2 = (acc[pt][2] + Dh * bflo(xv.y)) * siluf(bflo(zv.y)), y3 = (acc[pt][3] + Dh * bfhi(xv.y)) * siluf(bfhi(zv.y));
                    ssq += (y0 * y0 + y1 * y1) + (y2 * y2 + y3 * y3);
                    v2u o; o.x = pk2(y0, y1); o.y = pk2(y2, y3); *zp = o;
                }
                if (hh < 7) { *(v4u*)(ldsXn + xr * 144 + xq * 32) = nx0; *(v4u*)(ldsXn + xr * 144 + xq * 32 + 16) = nx1; }
                __syncthreads();
            }
            ssq += __shfl_xor(ssq, 16); ssq += __shfl_xor(ssq, 32);
            const float rstd = rsqrtf(ssq * (1.f / 512.f) + EPS);
#pragma unroll 1
            for (int hh = 0; hh < 8; ++hh)
#pragma unroll
                for (int pt = 0; pt < 4; ++pt) {
                    const int chn = 512 * g + 64 * hh + 16 * pt + 4 * gq; const f32x4 nw = *(const f32x4*)(ssd_norm_w + chn);
                    v2u* zp = (v2u*)(Z + (row0 + lrow) * DI + chn); if (DRY(6)) zp = (v2u*)(HALO + ((((row0 + lrow) * DI + chn)) & 0xFFFFC)); const v2u yv = *zp;
                    v2u o; o.x = pk2(bflo(yv.x) * rstd * nw.x, bfhi(yv.x) * rstd * nw.y); o.y = pk2(bflo(yv.y) * rstd * nw.z, bfhi(yv.y) * rstd * nw.w);
                    *zp = o;
                }
            __syncthreads();
        }
    }

    xcd_barrier(xbar);
    STAMP(8);
    REP(70)
    {
        PHASE_IDS
        pg8::Gemm g{H, Win_t + (size_t)6144 * D, T, 2048, D}; pg8::StaticOrder S; S.init(T, 2048, G, (int)blockIdx.x);
        pg8::EpiMk<1> E{}; E.O0 = GATES; E.ldc = 2048;
        pg8::gemm_phase<pg8::EpiMk<1>, pg8::StaticOrder, true, true>(gl, g, S, E);
        LAS float* scr = (LAS float*)(gl + wave * 16384);
        for (int it = gw; it < 4096; it += NGW) {
            if (it < 2048) transpose_item(w_up, FF, (it / 128) * 64, (it % 128) * 32, Wup_t, D, (it % 128) * 32, scr, lane);
            else { const int r = it - 2048; transpose_item(w_down, D, (r / 32) * 64, (r % 32) * 32, Wdown_t, FF, (r % 32) * 32, scr, lane); }
        }
    }
    xcd_barrier(xbar);
    STAMP(9);
    REP(71)
    {
        pg8::Gemm g{Z, Wbssd_t, T, D, DI}; pg8::StaticOrder S; S.init(T, D, G, (int)blockIdx.x);
        pg8::EpiMk<3> E{}; E.O0 = MERGED; E.ldc = D; E.G = GATES; E.YP = YPOOL;
        pg8::gemm_phase<pg8::EpiMk<3>, pg8::StaticOrder, true, true>(gl, g, S, E);
    }
    xcd_barrier(xbar);
    STAMP(10);
    REP(8)
    {
        pg8::Gemm g{MERGED, Wout_t, T, D, D}; pg8::StaticOrder S; S.init(T, D, G, (int)blockIdx.x);
        pg8::EpiMk<4> E{}; E.ldc = D; E.X0 = x; E.OF = X1; E.gate = MOD + 2048;
        pg8::gemm_phase<pg8::EpiMk<4>, pg8::StaticOrder, true, true>(gl, g, S, E);
    }
    xcd_barrier(xbar);
    STAMP(11);
    REP(9)
    { PHASE_IDS
    for (int m = gw; m < T; m += NGW) { const float* md = MOD + (m >> 13) * NMOD; norm_mod_row(X1 + (size_t)m * D, norm_mlp_w, md + 4096, md + 3072, H2 + (size_t)m * D, lane); } }
    xcd_barrier(xbar);
    STAMP(12);
    REP(10)
    {
        pg8::Gemm g{H2, Wup_t, T, FF, D}; pg8::StaticOrder S; S.init(T, FF, G, (int)blockIdx.x);
        pg8::EpiMk<5> E{}; E.O0 = UPB; E.ldc = FF;
        pg8::gemm_phase<pg8::EpiMk<5>, pg8::StaticOrder, true, true>(gl, g, S, E);
    }
    xcd_barrier(xbar);
    STAMP(13);
    {
        pg8::Gemm g{UPB, Wdown_t, T, D, FF}; pg8::StaticOrder S; S.init(T, D, G, (int)blockIdx.x);
        pg8::EpiMk<4> E{}; E.ldc = D; E.X0 = X1; E.OF = X1; E.gate = MOD + 5120;
        pg8::gemm_phase<pg8::EpiMk<4>, pg8::StaticOrder, true, true>(gl, g, S, E);
    }
    xcd_barrier(xbar);
    STAMP(14);
    { PHASE_IDS
    for (int m = gw; m < T; m += NGW) {
        f32x4* xr = (f32x4*)(X1 + (size_t)m * D) + lane; f32x4 v[4]; float s = 0.f;
#pragma unroll
        for (int j = 0; j < 4; ++j) { v[j] = xr[64 * j]; s += (v[j].x * v[j].x + v[j].y * v[j].y) + (v[j].z * v[j].z + v[j].w * v[j].w); }
        const float rstd = rsqrtf(wave_sum(s) * (1.f / D) + EPS);
#pragma unroll
        for (int j = 0; j < 4; ++j) xr[64 * j] = v[j] * rstd * ((const f32x4*)norm_final_w)[lane + 64 * j];
    } }
#ifdef TPROBE
    xcd_barrier(xbar);
    STAMP(15);
    if (blockIdx.x == 0) {
        PHASE_IDS
        __syncthreads();
        const float A = (float)(TS[TA_HI] - TS[TA_LO]) * 0.01f, B = (float)(TS[TB_HI] - TS[TB_LO]) * 0.01f;
        if (tid == 0) P.out[0] += A;
        for (int k = 1 + tid; k <= 10000; k += 512) P.out[(size_t)k * 1024] += B;
    }
#endif
}

extern "C" void kernel_launch(void* const* d_in, const int* in_sizes, int n_in, void* d_out, int out_size, void* d_ws, size_t ws_size, hipStream_t stream) {
    static int grid_blocks = 0;
    if (!grid_blocks) {
        int dev = 0, cus = 0, per_cu = 0;
        hipGetDevice(&dev);
        hipDeviceGetAttribute(&cus, hipDeviceAttributeMultiprocessorCount, dev);
        hipFuncSetAttribute((const void*)mk_fwd, hipFuncAttributeMaxDynamicSharedMemorySize, LDS_BYTES);
        hipOccupancyMaxActiveBlocksPerMultiprocessor(&per_cu, (const void*)mk_fwd, 512, LDS_BYTES);
        if (per_cu < 1) { fprintf(stderr, "occupancy query reports %d blocks/CU\n", per_cu); per_cu = 1; }
        grid_blocks = cus * 1;
        if (n_in != 21 || ws_size < 256 * MiB) fprintf(stderr, "kernel_launch: unexpected n_in %d / ws_size %zu\n", n_in, ws_size);
    }
    (void)hipMemsetAsync((char*)d_ws + WS_BAR, 0, 16384, stream);
    Params p{};
    for (int i = 0; i < 21; ++i) p.in[i] = (const float*)d_in[i];
    p.out = (float*)d_out; p.ws = (unsigned char*)d_ws;
    void* args[] = {&p};
    hipError_t e = hipLaunchCooperativeKernel((const void*)mk_fwd, dim3(grid_blocks), dim3(512), args, LDS_BYTES, stream);
    if (e != hipSuccess) fprintf(stderr, "cooperative launch failed: %s (grid %d)\n", hipGetErrorString(e), grid_blocks);
}
```

```cpp
#include <hip/hip_runtime.h>
#include <hip/hip_cooperative_groups.h>
#include <cstdio>
#include <cstdint>
namespace cg = cooperative_groups;
#ifndef DUP_PH
#define DUP_PH -1
#endif
#define DRY(n) (((DUP_PH) == (n)) && rep_ == 0)
#define REP(n) _Pragma("clang loop unroll(disable)") for (int rep_ = 0; rep_ < ((DUP_PH) == (n) ? 2 : 1); ++rep_)
namespace pg8 {
#define PG8_LAS __attribute__((address_space(3)))
typedef unsigned short bf16_t;
typedef short bf16x8 __attribute__((ext_vector_type(8)));
typedef float f32x4 __attribute__((ext_vector_type(4)));
typedef unsigned u32x4 __attribute__((ext_vector_type(4)));
constexpr int BM = 256, BK = 64, HALF = 128, HTB = HALF * BK * 2  , STAGE_BYTES = 8 * HTB, NXCD = 8, WGM = 8;

__host__ __device__ __forceinline__ int lds_byte(int r, int c) { const int st = (r >> 4) * 2 + (c >> 5), rr = r & 15, cc = c & 31, ob = rr * 64 + cc * 2; return st * 1024 + (ob ^ (((ob >> 9) & 1) << 5)); }
__host__ __device__ __forceinline__ void stage_rc(int b, int& R, int& C) { const int st = b / 1024, sb = b % 1024, swz = sb ^ (((sb >> 9) & 1) << 5); R = (st >> 1) * 16 + swz / 64; C = (st & 1) * 32 + (swz % 64) / 2; }
__host__ __device__ __forceinline__ int perm32(int rho) { const int n = rho >> 4, i = rho & 15; return 8 * (i >> 2) + 4 * n + (i & 3); }

struct Unit { int pm, pn; };
struct Gemm { const bf16_t* A; const bf16_t* Bt; int M, N, K; };

struct StaticOrder {
    int nM, nN, nwg, G, c;
    __host__ __device__ void init(int M, int N, int G_, int c_) { nM = M / BM; nN = N / BM; nwg = nM * nN; G = G_; c = c_; }
    __host__ __device__ bool next(int i, Unit& u) const {
        const long L = (long)i * G + c; if (L >= nwg) return false;
        int wgid = (int)L; { const int q = nwg / NXCD, r = nwg % NXCD, xcd = wgid % NXCD, off = wgid / NXCD; wgid = (xcd < r ? xcd * (q + 1) : r * (q + 1) + (xcd - r) * q) + off; }
        const int nig = WGM * nN, gid = wgid / nig, fm = gid * WGM, gsz = (nM - fm) < WGM ? (nM - fm) : WGM;
        u.pm = fm + ((wgid % nig) % gsz); u.pn = (wgid % nig) / gsz; return true;
    }
    __device__ __forceinline__ void a_ready(const Unit&) const {}
    __device__ __forceinline__ void done(const Unit&) const {}
};

typedef float f32x2c __attribute__((ext_vector_type(2))); typedef __bf16 bf16x2c __attribute__((ext_vector_type(2)));
__device__ __forceinline__ unsigned cvt_pk_bf16(float lo, float hi) { f32x2c v = {lo, hi}; bf16x2c b = __builtin_convertvector(v, bf16x2c); return __builtin_bit_cast(unsigned, b); }
template <int MODE> struct EpiMk {
    static constexpr bool PERM = true, AFTER_DRAIN = false;
    bf16_t* O0; bf16_t* O1; bf16_t* O2; bf16_t* halo; int ldc;
    const bf16_t* G; const bf16_t* YP; const float* X0; float* OF; const float* gate;
    __device__ __forceinline__ void operator()(const f32x4 (&acc)[2][2][4][2], const Unit& u, int wr, int wc, int fr, int fq) const {
        const int row0 = u.pm * BM + wr * 64 + fr;
        int colt = u.pn * BM; bf16_t* base = O0; int ld = ldc; bool dohalo = false;
        if constexpr (MODE == 0) {
            if (u.pn < 8) { base = O0; ld = 2048; }
            else if (u.pn < 20) { base = O1; ld = 3072; colt -= 2048; dohalo = true; }
            else { base = O2; ld = 1024; colt -= 5120; }
        }
        const int col0 = colt + wc * 32 + 8 * fq;
#pragma unroll
        for (int ai = 0; ai < 2; ++ai)
#pragma unroll
            for (int m = 0; m < 4; ++m) {
                const int row = row0 + ai * HALF + m * 16;
#pragma unroll
                for (int bj = 0; bj < 2; ++bj) {
                    const int col = col0 + bj * HALF;
                    f32x4 v0 = acc[ai][bj][m][0], v1 = acc[ai][bj][m][1];
                    if constexpr (MODE == 4) {
                        const float* gp = gate + (row >= 8192 ? 6144 : 0) + col;
                        const f32x4 g0 = *(const f32x4*)gp, g1 = *(const f32x4*)(gp + 4);
                        const float* xp = X0 + (size_t)row * ld + col;
                        const f32x4 x0 = *(const f32x4*)xp, x1 = *(const f32x4*)(xp + 4);
                        float* op = OF + (size_t)row * ld + col;
                        *(f32x4*)op = x0 + g0 * v0; *(f32x4*)(op + 4) = x1 + g1 * v1;
                    } else {
                        if constexpr (MODE == 1) {
#pragma unroll
                            for (int e = 0; e < 4; ++e) { v0[e] = 1.f / (1.f + __expf(-v0[e])); v1[e] = 1.f / (1.f + __expf(-v1[e])); }
                        }
                        if constexpr (MODE == 5) {
#pragma unroll
                            for (int e = 0; e < 4; ++e) { float a = fmaxf(v0[e], 0.f), b = fmaxf(v1[e], 0.f); v0[e] = a * a; v1[e] = b * b; }
                        }
                        if constexpr (MODE == 3) {
                            const u32x4 gs = *(const u32x4*)(G + (size_t)row * 2048 + col);
                            const u32x4 gq = *(const u32x4*)(G + (size_t)row * 2048 + 1024 + col);
                            const u32x4 yp = *(const u32x4*)(YP + (size_t)row * 1024 + col);
#pragma unroll
                            for (int e = 0; e < 2; ++e) {
                                v0[2 * e] = __builtin_bit_cast(float, gs[e] << 16) * v0[2 * e] + __builtin_bit_cast(float, gq[e] << 16) * __builtin_bit_cast(float, yp[e] << 16);
                                v0[2 * e + 1] = __builtin_bit_cast(float, gs[e] & 0xffff0000u) * v0[2 * e + 1] + __builtin_bit_cast(float, gq[e] & 0xffff0000u) * __builtin_bit_cast(float, yp[e] & 0xffff0000u);
                                v1[2 * e] = __builtin_bit_cast(float, gs[2 + e] << 16) * v1[2 * e] + __builtin_bit_cast(float, gq[2 + e] << 16) * __builtin_bit_cast(float, yp[2 + e] << 16);
                                v1[2 * e + 1] = __builtin_bit_cast(float, gs[2 + e] & 0xffff0000u) * v1[2 * e + 1] + __builtin_bit_cast(float, gq[2 + e] & 0xffff0000u) * __builtin_bit_cast(float, yp[2 + e] & 0xffff0000u);
                            }
                        }
                        u32x4 w; w.x = cvt_pk_bf16(v0[0], v0[1]); w.y = cvt_pk_bf16(v0[2], v0[3]); w.z = cvt_pk_bf16(v1[0], v1[1]); w.w = cvt_pk_bf16(v1[2], v1[3]);
                        *(u32x4*)(base + (size_t)row * ld + col) = w;
                        if constexpr (MODE == 0) {
                            if (dohalo && (row & 127) >= 125) *(u32x4*)(halo + ((size_t)(row >> 7) * 3 + ((row & 127) - 125)) * 3072 + col) = w;
                        }
                    }
                }
            }
    }
};


template <class Epi, class Sched, bool ALIGN_EPI = false, bool SP2 = false>
__device__ __forceinline__ void gemm_phase(PG8_LAS unsigned char* lds, const Gemm g, const Sched& S, const Epi& E) {
    const int tid = threadIdx.x, wid = __builtin_amdgcn_readfirstlane(tid >> 6), lane = tid & 63, wr = wid >> 2, wc = wid & 3, fr = lane & 15, fq = lane >> 4;
    const int K = g.K, nt = K / BK;
    unsigned voffA[2], voffB[2];
#pragma unroll
    for (int i = 0; i < 2; ++i) { int R, C; stage_rc(tid * 16 + i * 8192, R, C); const int Rb = Epi::PERM ? ((R & ~31) + perm32(R & 31)) : R;
        voffA[i] = (unsigned)(R * K + C) * 2u; voffB[i] = (unsigned)(Rb * K + C) * 2u; }
    const size_t kstep = (size_t)(BK * 2);
    const size_t hstep = (size_t)HALF * K * 2;
    const size_t tstep = 2 * hstep;
    const unsigned ldsw = (unsigned)wid * 1024u;
    const int aoff = lds_byte(wr * 64 + fr, fq * 8), boff = lds_byte(wc * 32 + fr, fq * 8);
#define PG8_SA(b, h) (((b) * 2 + (h)) * HTB)
#define PG8_SB(b, h) ((4 + (b) * 2 + (h)) * HTB)
#define PG8_STAGE(bufoff, gbase, voff) do { _Pragma("unroll") for (int _i = 0; _i < 2; ++_i) \
        __builtin_amdgcn_global_load_lds((const unsigned*)((const char*)(gbase) + (voff)[_i]), (PG8_LAS unsigned*)(lds + (bufoff) + ldsw + _i * 8192), 16, 0, 0); } while (0)
#define PG8_LDA(dst, b, h) do { _Pragma("unroll") for (int m = 0; m < 4; ++m) _Pragma("unroll") for (int k = 0; k < 2; ++k) dst[m][k] = *(const PG8_LAS bf16x8*)(lds + PG8_SA(b, h) + aoff + m * 2048 + k * 1024); } while (0)
#define PG8_LDB(dst, b, h) do { _Pragma("unroll") for (int n = 0; n < 2; ++n) _Pragma("unroll") for (int k = 0; k < 2; ++k) dst[n][k] = *(const PG8_LAS bf16x8*)(lds + PG8_SB(b, h) + boff + n * 2048 + k * 1024); } while (0)
#define PG8_MMA(ai, bj, At, Bt) do { __builtin_amdgcn_s_setprio(1); _Pragma("unroll") for (int m = 0; m < 4; ++m) _Pragma("unroll") for (int n = 0; n < 2; ++n) _Pragma("unroll") for (int k = 0; k < 2; ++k) \
        acc[ai][bj][m][n] = __builtin_amdgcn_mfma_f32_16x16x32_bf16(Bt[n][k], At[m][k], acc[ai][bj][m][n], 0, 0, 0); __builtin_amdgcn_s_setprio(0); } while (0)
#define PG8_WAIT_V(n) asm volatile("s_waitcnt vmcnt(" #n ")" ::: "memory")
#define PG8_WAIT_L(n) asm volatile("s_waitcnt lgkmcnt(" #n ")" ::: "memory")
#define PG8_BAR __builtin_amdgcn_s_barrier()
#define PG8_SCHED __builtin_amdgcn_sched_barrier(0)
    Unit cur, nxt; int ui = 0;
    if (!S.next(0, cur)) return;
    f32x4 acc[2][2][4][2];
#pragma unroll
    for (int a = 0; a < 2; ++a)
#pragma unroll
        for (int b = 0; b < 2; ++b)
#pragma unroll
            for (int m = 0; m < 4; ++m)
#pragma unroll
                for (int n = 0; n < 2; ++n) acc[a][b][m][n] = (f32x4){0.f, 0.f, 0.f, 0.f};
    bf16x8 At[4][2], B0[2][2], B1[2][2];
    const char* cA = (const char*)g.A + (size_t)cur.pm * tstep; const char* cB = (const char*)g.Bt + (size_t)cur.pn * tstep;
    S.a_ready(cur);
    if constexpr (SP2) {
        PG8_STAGE(PG8_SB(0, 0), cB, voffB); PG8_STAGE(PG8_SB(0, 1), cB + hstep, voffB); PG8_STAGE(PG8_SA(0, 0), cA, voffA); PG8_STAGE(PG8_SA(0, 1), cA + hstep, voffA);
        if (wr == 1) PG8_BAR;
        PG8_WAIT_V(2); PG8_BAR;
        PG8_STAGE(PG8_SB(1, 0), cB + kstep, voffB); PG8_STAGE(PG8_SA(1, 0), cA + kstep, voffA); PG8_STAGE(PG8_SB(1, 1), cB + hstep + kstep, voffB);
        PG8_WAIT_V(6); PG8_BAR;
    } else {
        PG8_STAGE(PG8_SB(0, 0), cB, voffB); PG8_STAGE(PG8_SA(0, 0), cA, voffA); PG8_STAGE(PG8_SB(0, 1), cB + hstep, voffB); PG8_STAGE(PG8_SA(0, 1), cA + hstep, voffA);
        if (wr == 1) PG8_BAR;
        PG8_WAIT_V(4); PG8_BAR;
        PG8_STAGE(PG8_SB(1, 0), cB + kstep, voffB); PG8_STAGE(PG8_SA(1, 0), cA + kstep, voffA); PG8_STAGE(PG8_SB(1, 1), cB + hstep + kstep, voffB);
        PG8_WAIT_V(6); PG8_BAR;
    }
    for (;;) {
        const bool has_next = S.next(ui + 1, nxt);
        const char* nA = has_next ? (const char*)g.A + (size_t)nxt.pm * tstep : cA; const char* nB = has_next ? (const char*)g.Bt + (size_t)nxt.pn * tstep : cB;
        for (int t = 0; t < nt; t += 2) {
            const bool last = (t == nt - 2);
            const char* a1 = cA + (size_t)(t + 1) * kstep;
            const char* a2 = last ? nA : cA + (size_t)(t + 2) * kstep; const char* b2 = last ? nB : cB + (size_t)(t + 2) * kstep;
            const char* a3 = a2 + kstep; const char* b3 = b2 + kstep;
            if (last && has_next) S.a_ready(nxt);
            if constexpr (SP2) {
            PG8_LDB(B0, 0, 0); PG8_LDB(B1, 0, 1); PG8_SCHED; PG8_LDA(At, 0, 0); PG8_STAGE(PG8_SA(1, 1), a1 + hstep, voffA);
            PG8_WAIT_V(8); PG8_WAIT_L(0); PG8_BAR; PG8_MMA(0, 0, At, B0); PG8_MMA(0, 1, At, B1); PG8_BAR; PG8_SCHED;
            PG8_LDA(At, 0, 1); PG8_STAGE(PG8_SB(0, 0), b2, voffB); PG8_STAGE(PG8_SB(0, 1), b2 + hstep, voffB); PG8_STAGE(PG8_SA(0, 0), a2, voffA);
            PG8_WAIT_V(8); PG8_WAIT_L(0); PG8_BAR; PG8_MMA(1, 0, At, B0); PG8_MMA(1, 1, At, B1); PG8_BAR; PG8_SCHED;
            PG8_LDB(B0, 1, 0); PG8_LDB(B1, 1, 1); PG8_SCHED; PG8_LDA(At, 1, 0); PG8_STAGE(PG8_SA(0, 1), a2 + hstep, voffA);
            PG8_WAIT_V(8); PG8_WAIT_L(0); PG8_BAR; PG8_MMA(0, 0, At, B0); PG8_MMA(0, 1, At, B1); PG8_BAR; PG8_SCHED;
            PG8_LDA(At, 1, 1); PG8_STAGE(PG8_SB(1, 0), b3, voffB); PG8_STAGE(PG8_SB(1, 1), b3 + hstep, voffB); PG8_STAGE(PG8_SA(1, 0), a3, voffA);
            PG8_WAIT_V(8); PG8_WAIT_L(0); PG8_BAR; PG8_MMA(1, 0, At, B0); PG8_MMA(1, 1, At, B1); PG8_BAR; PG8_SCHED;
            } else {
            PG8_LDB(B0, 0, 0); PG8_SCHED; PG8_LDA(At, 0, 0); PG8_STAGE(PG8_SA(1, 1), a1 + hstep, voffA);
            PG8_WAIT_L(8); PG8_BAR; PG8_WAIT_L(0); PG8_MMA(0, 0, At, B0); PG8_BAR; PG8_SCHED;
            PG8_LDB(B1, 0, 1); PG8_STAGE(PG8_SB(0, 0), b2, voffB);
            PG8_BAR; PG8_WAIT_L(0); PG8_MMA(0, 1, At, B1); PG8_BAR;
            PG8_LDA(At, 0, 1); PG8_STAGE(PG8_SA(0, 0), a2, voffA);
            PG8_BAR; PG8_WAIT_L(0); PG8_MMA(1, 0, At, B0); PG8_BAR; PG8_SCHED;
            PG8_STAGE(PG8_SB(0, 1), b2 + hstep, voffB);
            PG8_WAIT_V(6); PG8_BAR; PG8_MMA(1, 1, At, B1); PG8_BAR;
            PG8_LDB(B0, 1, 0); PG8_SCHED; PG8_LDA(At, 1, 0); PG8_STAGE(PG8_SA(0, 1), a2 + hstep, voffA);
            PG8_WAIT_L(8); PG8_BAR; PG8_WAIT_L(0); PG8_MMA(0, 0, At, B0); PG8_BAR; PG8_SCHED;
            PG8_LDB(B1, 1, 1); PG8_STAGE(PG8_SB(1, 0), b3, voffB);
            PG8_BAR; PG8_WAIT_L(0); PG8_MMA(0, 1, At, B1); PG8_BAR;
            PG8_LDA(At, 1, 1); PG8_STAGE(PG8_SA(1, 0), a3, voffA);
            PG8_BAR; PG8_WAIT_L(0); PG8_MMA(1, 0, At, B0); PG8_BAR; PG8_SCHED;
            PG8_STAGE(PG8_SB(1, 1), b3 + hstep, voffB);
            PG8_WAIT_V(6); PG8_BAR; PG8_MMA(1, 1, At, B1); PG8_BAR;
            }
        }
        if constexpr (ALIGN_EPI) { if (wr == 0) PG8_BAR; }
        if constexpr (!Epi::AFTER_DRAIN) { E(acc, cur, wr, wc, fr, fq); S.done(cur); }
        if (!has_next) break;
#pragma unroll
        for (int a = 0; a < 2; ++a)
#pragma unroll
            for (int b = 0; b < 2; ++b)
#pragma unroll
                for (int m = 0; m < 4; ++m)
#pragma unroll
                    for (int n = 0; n < 2; ++n) acc[a][b][m][n] = (f32x4){0.f, 0.f, 0.f, 0.f};
        cur = nxt; cA = nA; cB = nB; ++ui;
        if constexpr (ALIGN_EPI) { if (wr == 1) PG8_BAR; }
    }
    PG8_WAIT_V(0);
    if constexpr (!ALIGN_EPI) { if (wr == 0) PG8_BAR; }
    PG8_BAR;
    if constexpr (Epi::AFTER_DRAIN) { E.fused(acc, cur, wr, wc, fr, fq, lds, wid, lane); S.done(cur); }
#undef PG8_SA
#undef PG8_SB
#undef PG8_STAGE
#undef PG8_LDA
#undef PG8_LDB
#undef PG8_MMA
#undef PG8_WAIT_V
#undef PG8_WAIT_L
#undef PG8_BAR
#undef PG8_SCHED
}
}
#define LAS __attribute__((address_space(3)))
typedef unsigned short bf16;
typedef unsigned v4u __attribute__((ext_vector_type(4)));
typedef unsigned v2u __attribute__((ext_vector_type(2)));
typedef float f32x4 __attribute__((ext_vector_type(4)));
typedef short bf16x8 __attribute__((ext_vector_type(8)));
typedef short s16x4 __attribute__((ext_vector_type(4)));
typedef short v4i16_t __attribute__((ext_vector_type(4)));

constexpr int T = 16384, SEQ = 8192, D = 1024, DI = 2048, XW = 3072, FF = 4096, NH = 32, NMOD = 6144, INC = 8224;
constexpr float EPS = 1e-5f;
constexpr size_t MiB = 1u << 20;
constexpr size_t WS_WIN = 0, WS_WBSSD = 16 * MiB, WS_WPP = 20 * MiB, WS_WOUT = 22 * MiB, WS_WDT = 24 * MiB, WS_MOD = 24 * MiB + 65536;
constexpr size_t WS_DT = 25 * MiB, WS_ACS = 27 * MiB, WS_HALO = 29 * MiB;
constexpr size_t WS_XBC = 32 * MiB, WS_GATES = 32 * MiB, WS_UP = 32 * MiB;
constexpr size_t WS_H = 128 * MiB, WS_MERGED = 128 * MiB;
constexpr size_t WS_UPOOL = 160 * MiB, WS_YPOOL = 160 * MiB, WS_H2 = 160 * MiB;
constexpr size_t WS_POOLED = 192 * MiB, WS_STATES = 192 * MiB, WS_WUP = 192 * MiB, WS_WDOWN = 200 * MiB;
constexpr int LDS_BYTES = 163840;

typedef float f32x2_t __attribute__((ext_vector_type(2))); typedef __bf16 bf16x2_t __attribute__((ext_vector_type(2)));
__device__ __forceinline__ unsigned pk2(float lo, float hi) { f32x2_t v = {lo, hi}; bf16x2_t b = __builtin_convertvector(v, bf16x2_t); return __builtin_bit_cast(unsigned, b); }
__device__ __forceinline__ float bflo(unsigned u) { return __builtin_bit_cast(float, u << 16); }
__device__ __forceinline__ float bfhi(unsigned u) { return __builtin_bit_cast(float, u & 0xffff0000u); }
__device__ __forceinline__ float wave_sum(float v) {
#pragma unroll
    for (int o = 1; o < 64; o <<= 1) v += __shfl_xor(v, o);
    return v;
}
__device__ __forceinline__ float siluf(float v) { return v / (1.f + __expf(-v)); }
__device__ __forceinline__ s16x4 ds_tr(const unsigned char* p) { return __builtin_bit_cast(s16x4, __builtin_amdgcn_ds_read_tr16_b64_v4i16((LAS v4i16_t*)p)); }
__device__ __forceinline__ bf16x8 cat8(s16x4 a, s16x4 b) { return __builtin_shufflevector(a, b, 0, 1, 2, 3, 4, 5, 6, 7); }
#define MFMA16(a, b, c) __builtin_amdgcn_mfma_f32_16x16x32_bf16((a), (b), (c), 0, 0, 0)

__device__ __forceinline__ void transpose_item(const float* W, int ldw, int k0, int c0, bf16* WT, int K, int drow0, LAS float* scr, int lane) {
#pragma unroll 8
    for (int i = 0; i < 32; ++i) { const int kk = 2 * i + (lane >> 5); scr[kk * 33 + (lane & 31)] = W[(size_t)(k0 + kk) * ldw + c0 + (lane & 31)]; }
    asm volatile("s_waitcnt lgkmcnt(0)" ::: "memory");
    const int c = lane & 7;
#pragma unroll
    for (int j = 0; j < 4; ++j) { const int n = (lane >> 3) + 8 * j; const LAS float* s = scr + (8 * c) * 33 + n;
        v4u o; o.x = pk2(s[0 * 33], s[1 * 33]); o.y = pk2(s[2 * 33], s[3 * 33]); o.z = pk2(s[4 * 33], s[5 * 33]); o.w = pk2(s[6 * 33], s[7 * 33]);
        *(v4u*)(WT + (size_t)(drow0 + n) * K + k0 + 8 * c) = o; }
    asm volatile("s_waitcnt lgkmcnt(0)" ::: "memory");
}

__device__ __forceinline__ void norm_mod_row(const float* xrow, const float* w, const float* scale, const float* shift, bf16* orow, int lane) {
    const f32x4* xr = (const f32x4*)xrow + lane;
    f32x4 v[4]; float s = 0.f;
#pragma unroll
    for (int j = 0; j < 4; ++j) { v[j] = xr[64 * j]; s += (v[j].x * v[j].x + v[j].y * v[j].y) + (v[j].z * v[j].z + v[j].w * v[j].w); }
    const float rstd = rsqrtf(wave_sum(s) * (1.f / D) + EPS);
    v2u* o8 = (v2u*)orow + lane;
#pragma unroll
    for (int j = 0; j < 4; ++j) {
        const f32x4 ww = ((const f32x4*)w)[lane + 64 * j], sc = ((const f32x4*)scale)[lane + 64 * j], sh = ((const f32x4*)shift)[lane + 64 * j];
        f32x4 r = v[j] * rstd * ww * (sc + 1.f) + sh;
        v2u o; o.x = pk2(r.x, r.y); o.y = pk2(r.z, r.w); o8[64 * j] = o;
    }
}

#define XB_TMO      128
#define XB_XCNT(j)  (256  + 64 * (j))
#define XB_XSUB(j)  (1280 + 64 * (j))
#define XB_XGEN(j)  (2304 + 64 * (j))
#define XB_TOP      3328
#define XB_TOPGEN   3392
#define XCD_BAR_WORDS 3456
#define XB_SPIN_CAP (1u << 18)

__device__ __forceinline__ unsigned xb_ld(unsigned* p)              { return __hip_atomic_load(p, __ATOMIC_RELAXED, __HIP_MEMORY_SCOPE_AGENT); }
__device__ __forceinline__ unsigned xb_add(unsigned* p, unsigned v) { return __hip_atomic_fetch_add(p, v, __ATOMIC_RELAXED, __HIP_MEMORY_SCOPE_AGENT); }
__device__ __forceinline__ unsigned xb_xcc_id() { return (unsigned)__builtin_amdgcn_s_getreg((3 << 11) | 20) & 0xFu; }
#define XB_SPIN(cond, bar) do { unsigned _sp = 0; while (cond) { __builtin_amdgcn_s_sleep(1); \
    if ((++_sp & 255u) == 0u) { if (xb_ld(&(bar)[XB_TMO])) break; if (_sp > XB_SPIN_CAP) { atomicAdd(&(bar)[XB_TMO], 1u); break; } } } } while (0)

struct XcdBarrier {
    unsigned* bar; unsigned x;
    volatile LAS unsigned* st;
};

__device__ __forceinline__ XcdBarrier xcd_barrier_post(unsigned* bar, volatile LAS unsigned* st) {
    XcdBarrier b; b.bar = bar; b.x = xb_xcc_id(); b.st = st;
    if (threadIdx.x == 0) (void)xb_add(&bar[XB_XCNT(b.x)], 1u);
    return b;
}
__device__ __forceinline__ void xcd_barrier_complete(unsigned* bar, unsigned x, unsigned& nloc, unsigned& nx) {
    const unsigned G = gridDim.x * gridDim.y * gridDim.z;
    unsigned sum, cnt, mine, sp = 0u;
    for (;;) {
        sum = 0u; cnt = 0u; mine = 0u;
#pragma unroll
        for (unsigned j = 0; j < 16; ++j) { const unsigned c = xb_ld(&bar[XB_XCNT(j)]); sum += c; cnt += (c > 0u) ? 1u : 0u; mine = (j == x) ? c : mine; }
        if (sum == G) break;
        __builtin_amdgcn_s_sleep(1);
        if ((++sp & 255u) == 0u) { if (xb_ld(&bar[XB_TMO])) break; if (sp > XB_SPIN_CAP) { atomicAdd(&bar[XB_TMO], 1u); break; } }
    }
    nloc = mine > 0u ? mine : 1u; nx = cnt > 0u ? cnt : 1u;
}

__device__ __forceinline__ void xcd_barrier(const XcdBarrier& b) {
    asm volatile("s_waitcnt vmcnt(0)" ::: "memory");
    __syncthreads();
    if (threadIdx.x == 0) {
        unsigned* bar = b.bar;
        __builtin_amdgcn_s_waitcnt(0);
        unsigned nloc = b.st[0], nx = b.st[1];
        if (nloc == 0u) { xcd_barrier_complete(bar, b.x, nloc, nx); b.st[0] = nloc; b.st[1] = nx; }
        const unsigned old = xb_add(&bar[XB_XSUB(b.x)], 1u);
        const unsigned gen = old / nloc;
        if (old + 1u == (gen + 1u) * nloc) {
            __builtin_amdgcn_fence(__ATOMIC_RELEASE, "agent");
            asm volatile("s_waitcnt vmcnt(0)" ::: "memory");
            const unsigned og = xb_add(&bar[XB_TOP], 1u);
            const unsigned tg = og / nx;
            if (og + 1u == (tg + 1u) * nx) xb_add(&bar[XB_TOPGEN], 1u);
            else XB_SPIN(xb_ld(&bar[XB_TOPGEN]) == tg, bar);
            __builtin_amdgcn_fence(__ATOMIC_ACQUIRE, "agent");
            xb_add(&bar[XB_XGEN(b.x)], 1u);
            asm volatile("s_waitcnt vmcnt(0)" ::: "memory");
        } else {
            XB_SPIN(xb_ld(&bar[XB_XGEN(b.x)]) == gen, bar);
            __builtin_amdgcn_fence(__ATOMIC_ACQUIRE, "agent");
            asm volatile("s_waitcnt vmcnt(0)" ::: "memory");
        }
    }
    __syncthreads();
}

constexpr size_t WS_BAR = 24 * MiB + 131072;
struct Params { const float* in[21]; float* out; unsigned char* ws; };

__global__ void __launch_bounds__(512, 2) mk_fwd(Params P) {
    extern __shared__ __attribute__((aligned(16))) unsigned char lds[];
    cg::grid_group grid = cg::this_grid();
#define PHASE_IDS int tid = threadIdx.x; asm volatile("" : "+v"(tid)); const int lane = tid & 63, wave = __builtin_amdgcn_readfirstlane(tid >> 6), gw = blockIdx.x * 8 + wave; (void)lane; (void)wave; (void)gw;
    const int G = gridDim.x, NGW = G * 8;
    unsigned char* ws = P.ws;
    const float* x = P.in[0]; const float* cvec = P.in[1]; const float* w_ada = P.in[2]; const float* b_ada = P.in[3]; const float* norm_mix_w = P.in[4];
    const float* w_in = P.in[5]; const float* conv_w = P.in[6]; const float* conv_b = P.in[7]; const float* dt_bias = P.in[8]; const float* a_log = P.in[9];
    const float* d_skip = P.in[10]; const float* ssd_norm_w = P.in[11]; const float* w_bssd = P.in[12]; const float* pool_w = P.in[13]; const float* pool_scale = P.in[14];
    const float* w_bpool = P.in[15]; const float* w_out = P.in[16]; const float* norm_mlp_w = P.in[17]; const float* w_up = P.in[18]; const float* w_down = P.in[19];
    const float* norm_final_w = P.in[20];
    bf16* Win_t = (bf16*)(ws + WS_WIN); bf16* Wbssd_t = (bf16*)(ws + WS_WBSSD); bf16* Wpp_t = (bf16*)(ws + WS_WPP); bf16* Wout_t = (bf16*)(ws + WS_WOUT);
    bf16* Wdt_t = (bf16*)(ws + WS_WDT); float* MOD = (float*)(ws + WS_MOD); float* DT = (float*)(ws + WS_DT); float* ACS = (float*)(ws + WS_ACS);
    bf16* HALO = (bf16*)(ws + WS_HALO); bf16* XBC = (bf16*)(ws + WS_XBC); bf16* GATES = (bf16*)(ws + WS_GATES); bf16* UPB = (bf16*)(ws + WS_UP);
    bf16* H = (bf16*)(ws + WS_H); bf16* MERGED = (bf16*)(ws + WS_MERGED); bf16* UPOOL = (bf16*)(ws + WS_UPOOL); bf16* YPOOL = (bf16*)(ws + WS_YPOOL);
    bf16* H2 = (bf16*)(ws + WS_H2); bf16* POOLED = (bf16*)(ws + WS_POOLED); bf16* STATES = (bf16*)(ws + WS_STATES); bf16* Wup_t = (bf16*)(ws + WS_WUP);
    bf16* Wdown_t = (bf16*)(ws + WS_WDOWN);
    bf16* Z = (bf16*)P.out;
    float* X1 = P.out;
    LAS unsigned char* gl = (LAS unsigned char*)lds;
    volatile LAS unsigned* xst = (volatile LAS unsigned*)(gl + LDS_BYTES - 16);
    if (threadIdx.x < 4) xst[threadIdx.x] = 0u;
    __syncthreads();
    const XcdBarrier xbar = xcd_barrier_post((unsigned*)(P.ws + WS_BAR), xst);
    if (P.ws == nullptr) grid.sync();
#ifdef TPROBE
    unsigned long long* TS = (unsigned long long*)(ws + 24 * MiB + 131072);
#define STAMP(k) do { if (blockIdx.x == 0 && threadIdx.x == 0) TS[k] = __builtin_amdgcn_s_memrealtime(); } while (0)
#else
#define STAMP(k) do {} while (0)
#endif
    STAMP(0);

    REP(0)
    {
        PHASE_IDS
        LAS float* red = (LAS float*)gl;
        for (int it = blockIdx.x; it < 192; it += G) {
            const int j = it * 32 + (lane & 31), kb = wave * 128 + (lane >> 5) * 64; float a0 = 0.f, a1 = 0.f;
#pragma unroll 16
            for (int k = kb; k < kb + 64; ++k) { const float w = w_ada[(size_t)k * NMOD + j]; a0 += siluf(cvec[k]) * w; a1 += siluf(cvec[1024 + k]) * w; }
            red[(wave * 2 + (lane >> 5)) * 64 + (lane & 31)] = a0; red[(wave * 2 + (lane >> 5)) * 64 + 32 + (lane & 31)] = a1; __syncthreads();
            if (tid < 64) { float s = 0.f;
#pragma unroll
                for (int q = 0; q < 16; ++q) s += red[q * 64 + tid];
                const int jj = it * 32 + (tid & 31); MOD[(tid >> 5) * NMOD + jj] = s + b_ada[jj]; }
            __syncthreads();
        }
        LAS float* scr = (LAS float*)(gl + wave * 16384);
        constexpr int I_IN = 16 * 257, I_BS = 32 * 32, I_O = 16 * 32;
        for (int it = gw; it < I_IN + I_BS + I_O; it += NGW) {
            int r = it;
            if (r < I_IN) { const int kb = r / 257, nb = r % 257; const int c0 = nb * 32;
                if (nb == 160) transpose_item(w_in, INC, kb * 64, c0, Wdt_t, D, 0, scr, lane);
                else transpose_item(w_in, INC, kb * 64, c0, Win_t, D, nb < 160 ? c0 : c0 - 32, scr, lane);
                continue; } r -= I_IN;
            if (r < I_BS) { transpose_item(w_bssd, D, (r / 32) * 64, (r % 32) * 32, Wbssd_t, DI, (r % 32) * 32, scr, lane); continue; } r -= I_BS;
            transpose_item(w_out, D, (r / 32) * 64, (r % 32) * 32, Wout_t, D, (r % 32) * 32, scr, lane);
        }
        for (int e = blockIdx.x * 512 + tid; e < 65536; e += G * 512) {
            const int nq = e & 255, kq = __builtin_amdgcn_readfirstlane(e >> 8), k0 = 4 * kq, n0 = 4 * nq, g = k0 >> 8;
            const float* pw = pool_w + (size_t)k0 * 256; const float* ps = pool_scale + g * 256; const float* wb = w_bpool + (size_t)g * 256 * D + n0;
            f32x4 acc4[4];
#pragma unroll
            for (int i = 0; i < 4; ++i) acc4[i] = (f32x4){0.f, 0.f, 0.f, 0.f};
#pragma unroll 8
            for (int j = 0; j < 256; ++j) { const f32x4 bv = *(const f32x4*)(wb + (size_t)j * D); const float sj = ps[j];
#pragma unroll
                for (int i = 0; i < 4; ++i) acc4[i] += bv * (pw[i * 256 + j] * sj); }
#pragma unroll
            for (int c = 0; c < 4; ++c) { v2u o; o.x = pk2(acc4[0][c], acc4[1][c]); o.y = pk2(acc4[2][c], acc4[3][c]); *(v2u*)(Wpp_t + (size_t)(n0 + c) * D + k0) = o; }
        }
    }
    xcd_barrier(xbar);
    STAMP(1);
    REP(1)
    { PHASE_IDS
    for (int m = gw; m < T; m += NGW) { const float* md = MOD + (m >> 13) * NMOD; norm_mod_row(x + (size_t)m * D, norm_mix_w, md + 1024, md, H + (size_t)m * D, lane); } }
    xcd_barrier(xbar);
    STAMP(2);
    REP(2)
    {
        PHASE_IDS
        pg8::Gemm g{H, Win_t, T, 6144, D}; pg8::StaticOrder S; S.init(T, 6144, G, (int)blockIdx.x);
        pg8::EpiMk<0> E{}; E.O0 = Z; E.O1 = XBC; E.O2 = UPOOL; E.halo = HALO; E.ldc = 0;
        pg8::gemm_phase<pg8::EpiMk<0>, pg8::StaticOrder, true, true>(gl, g, S, E);
        const int gq = lane >> 4, i = lane & 15;
        REP(21)
        for (int it = gw; it < T / 16; it += NGW) {
            const int r0 = it * 16; f32x4 a0 = {0.f, 0.f, 0.f, 0.f}, a1 = {0.f, 0.f, 0.f, 0.f};
#pragma unroll 4
            for (int ks = 0; ks < 32; ++ks) {
                const bf16x8 af = *(const bf16x8*)(H + (size_t)(r0 + i) * D + 32 * ks + 8 * gq);
                const bf16x8 b0 = *(const bf16x8*)(Wdt_t + (size_t)i * D + 32 * ks + 8 * gq), b1 = *(const bf16x8*)(Wdt_t + (size_t)(16 + i) * D + 32 * ks + 8 * gq);
                a0 = MFMA16(af, b0, a0); a1 = MFMA16(af, b1, a1);
            }
#pragma unroll
            for (int r = 0; r < 4; ++r) { DT[(size_t)(r0 + 4 * gq + r) * NH + i] = a0[r]; DT[(size_t)(r0 + 4 * gq + r) * NH + 16 + i] = a1[r]; }
        }
    }
    xcd_barrier(xbar);
    STAMP(3);
    {
        PHASE_IDS
        const int tx = tid & 63, ty = tid >> 6;
        REP(30)
        for (int it = blockIdx.x; it < 768; it += G) {
            const int ch = it / 6, cb = it % 6; const int ch0 = cb * 512 + tx * 8; const size_t row0 = (size_t)ch * 128 + ty * 16;
            v4u raw[19];
#pragma unroll
            for (int r = 0; r < 16; ++r) raw[3 + r] = *(const v4u*)(XBC + (row0 + r) * XW + ch0);
            if (ty > 0) {
#pragma unroll
                for (int r = 0; r < 3; ++r) raw[r] = *(const v4u*)(XBC + (row0 - 3 + r) * XW + ch0);
            } else if ((ch & 63) != 0) {
#pragma unroll
                for (int r = 0; r < 3; ++r) raw[r] = *(const v4u*)(HALO + ((size_t)(ch - 1) * 3 + r) * XW + ch0);
            } else {
#pragma unroll
                for (int r = 0; r < 3; ++r) raw[r] = (v4u){0u, 0u, 0u, 0u};
            }
            asm volatile("s_waitcnt vmcnt(0)" ::: "memory"); __syncthreads();
            float wv[4][8], bv[8];
#pragma unroll
            for (int k = 0; k < 4; ++k) { const f32x4 a = *(const f32x4*)(conv_w + (size_t)k * XW + ch0), b = *(const f32x4*)(conv_w + (size_t)k * XW + ch0 + 4);
                wv[k][0] = a.x; wv[k][1] = a.y; wv[k][2] = a.z; wv[k][3] = a.w; wv[k][4] = b.x; wv[k][5] = b.y; wv[k][6] = b.z; wv[k][7] = b.w; }
            { const f32x4 a = *(const f32x4*)(conv_b + ch0), b = *(const f32x4*)(conv_b + ch0 + 4); bv[0] = a.x; bv[1] = a.y; bv[2] = a.z; bv[3] = a.w; bv[4] = b.x; bv[5] = b.y; bv[6] = b.z; bv[7] = b.w; }
#pragma unroll
            for (int r = 0; r < 16; ++r) {
                v4u o;
#pragma unroll
                for (int e = 0; e < 4; ++e) {
                    float lo = bv[2 * e], hi = bv[2 * e + 1];
#pragma unroll
                    for (int k = 0; k < 4; ++k) { const unsigned u = raw[r + k][e]; lo += wv[k][2 * e] * bflo(u); hi += wv[k][2 * e + 1] * bfhi(u); }
                    o[e] = pk2(siluf(lo), siluf(hi));
                }
                *(v4u*)((DRY(30) ? STATES + 16777216 + (((row0 + r) * XW) & 0x7FFFFF) : XBC + (row0 + r) * XW) + ch0) = o;
            }
        }
        REP(31)
        for (int e = blockIdx.x * 512 + tid; e < 1024 * 128; e += G * 512) {
            const int c8 = (e & 127) * 8, t0 = (e >> 7) * 16, gi = c8 >> 8, win = 2 << gi, pos0 = t0 & (SEQ - 1);
            const bf16* up = UPOOL + (size_t)t0 * D + c8;
            float s[8];
#pragma unroll
            for (int q = 0; q < 8; ++q) s[q] = 0.f;
#pragma unroll
            for (int j = 1; j < 16; ++j) if (j < win && pos0 - j >= 0) { const v4u v = *(const v4u*)(up - (size_t)j * D);
#pragma unroll
                for (int q = 0; q < 4; ++q) { s[2 * q] += bflo(v[q]); s[2 * q + 1] += bfhi(v[q]); } }
#pragma unroll 4
            for (int r = 0; r < 16; ++r) {
                const v4u v = *(const v4u*)(up + (size_t)r * D); const int pos = pos0 + r; const int cnt = (pos + 1 < win) ? pos + 1 : win; const float inv = 1.f / (float)cnt;
                v4u o;
#pragma unroll
                for (int q = 0; q < 4; ++q) { const float lo = bflo(v[q]), hi = bfhi(v[q]); s[2 * q] += lo; s[2 * q + 1] += hi; o[q] = pk2(s[2 * q] * inv - lo, s[2 * q + 1] * inv - hi); }
                *(v4u*)(POOLED + (size_t)(t0 + r) * D + c8) = o;
                if (pos - win + 1 >= 0) { const v4u w = *(const v4u*)(up + (size_t)(r - win + 1) * D);
#pragma unroll
                    for (int q = 0; q < 4; ++q) { s[2 * q] -= bflo(w[q]); s[2 * q + 1] -= bfhi(w[q]); } }
            }
        }
        for (int it = gw; it < 128 * NH; it += NGW) {
            const int ch = it >> 5, h = it & 31; const size_t r0 = (size_t)ch * 128 + 2 * lane; const float bias = dt_bias[h], A = -__expf(a_log[h]);
            float v0 = DT[r0 * NH + h] + bias, v1 = DT[(r0 + 1) * NH + h] + bias;
            const float d0 = v0 > 20.f ? v0 : log1pf(__expf(v0)), d1 = v1 > 20.f ? v1 : log1pf(__expf(v1));
            const float a0 = d0 * A, a1 = d1 * A; float incl = a0 + a1;
#pragma unroll
            for (int o = 1; o < 64; o <<= 1) { const float n = __shfl_up(incl, o); if (lane >= o) incl += n; }
            const float excl = incl - (a0 + a1);
            DT[r0 * NH + h] = d0; DT[(r0 + 1) * NH + h] = d1; ACS[r0 * NH + h] = excl + a0; ACS[(r0 + 1) * NH + h] = excl + a0 + a1;
        }
    }
    xcd_barrier(xbar);
    STAMP(4);
    REP(35)
    {
        pg8::Gemm g{POOLED, Wpp_t, T, D, D}; pg8::StaticOrder S; S.init(T, D, G, (int)blockIdx.x);
        pg8::EpiMk<2> E{}; E.O0 = YPOOL; E.ldc = D;
        pg8::gemm_phase<pg8::EpiMk<2>, pg8::StaticOrder, true, true>(gl, g, S, E);
    }

    xcd_barrier(xbar);
    STAMP(5);
    REP(4)
    {
        PHASE_IDS
        const int gq = lane >> 4, li = lane & 15, lr = li >> 2, lc = li & 3;
        unsigned char* ldsB = lds; unsigned char* ldsX = lds + 34816;
        for (int it = blockIdx.x; it < 512; it += G) {
            const int bc = it >> 2, g = it & 3; const size_t row0 = (size_t)bc * 128;
            for (int q = tid; q < 2048; q += 512) { const int r = q >> 4, c16 = q & 15; *(v4u*)(ldsB + r * 272 + c16 * 16) = *(const v4u*)(XBC + (row0 + r) * XW + 2048 + g * 128 + c16 * 8); }
            __syncthreads();
            bf16x8 Af[4];
#pragma unroll
            for (int ks = 0; ks < 4; ++ks) Af[ks] = cat8(ds_tr(ldsB + (32 * ks + 8 * gq + lr) * 272 + (16 * wave + 4 * lc) * 2), ds_tr(ldsB + (32 * ks + 8 * gq + 4 + lr) * 272 + (16 * wave + 4 * lc) * 2));
#pragma unroll 1
            for (int hh = 0; hh < 8; ++hh) {
                const int h = 8 * g + hh;
                { const int r = tid >> 2, qc = tid & 3;
                  const float sc = DT[(row0 + r) * NH + h] * __expf(ACS[(row0 + 127) * NH + h] - ACS[(row0 + r) * NH + h]);
#pragma unroll
                  for (int e = 0; e < 2; ++e) { const v4u v = *(const v4u*)(XBC + (row0 + r) * XW + h * 64 + qc * 16 + e * 8); v4u o;
#pragma unroll
                      for (int q = 0; q < 4; ++q) o[q] = pk2(bflo(v[q]) * sc, bfhi(v[q]) * sc);
                      *(v4u*)(ldsX + r * 144 + (qc * 16 + e * 8) * 2) = o; } }
                __syncthreads();
                f32x4 acc[4];
#pragma unroll
                for (int pt = 0; pt < 4; ++pt) acc[pt] = (f32x4){0.f, 0.f, 0.f, 0.f};
#pragma unroll
                for (int ks = 0; ks < 4; ++ks)
#pragma unroll
                    for (int pt = 0; pt < 4; ++pt) {
                        const bf16x8 bx = cat8(ds_tr(ldsX + (32 * ks + 8 * gq + lr) * 144 + (16 * pt + 4 * lc) * 2), ds_tr(ldsX + (32 * ks + 8 * gq + 4 + lr) * 144 + (16 * pt + 4 * lc) * 2));
                        acc[pt] = MFMA16(Af[ks], bx, acc[pt]);
                    }
                bf16* st = STATES + ((size_t)bc * NH + h) * 8192;
#pragma unroll
                for (int pt = 0; pt < 4; ++pt) { v2u o; o.x = pk2(acc[pt][0], acc[pt][1]); o.y = pk2(acc[pt][2], acc[pt][3]); *(v2u*)(st + (16 * pt + li) * 128 + 16 * wave + 4 * gq) = o; }
                __syncthreads();
            }
        }
    }
    xcd_barrier(xbar);
    STAMP(6);
    REP(5)
    { PHASE_IDS
    for (int e = blockIdx.x * 512 + tid; e < 131072; e += G * 512) {
        const int n4 = e & 31, p = (e >> 5) & 63, h = (e >> 11) & 31, b = e >> 16;
        float s0 = 0.f, s1 = 0.f, s2 = 0.f, s3 = 0.f;
#pragma unroll 8
        for (int c = 0; c < 64; ++c) {
            v2u* ptr = (v2u*)(STATES + (((size_t)(b * 64 + c) * NH + h) * 64 + p) * 128 + n4 * 4);
            const v2u v = *ptr; const float d = __expf(ACS[((size_t)b * SEQ + c * 128 + 127) * NH + h]);
            v2u o; o.x = pk2(s0, s1); o.y = pk2(s2, s3); *(DRY(5) ? (v2u*)(HALO) + (((size_t)c * 131072 + e) & 0x3FFFF) : ptr) = o;
            s0 = s0 * d + bflo(v.x); s1 = s1 * d + bfhi(v.x); s2 = s2 * d + bflo(v.y); s3 = s3 * d + bfhi(v.y);
        }
    } }

    xcd_barrier(xbar);
    STAMP(7);
    REP(6)
    {
        PHASE_IDS
        const int gq = lane >> 4, li = lane & 15, lr = li >> 2, lc = li & 3;
        unsigned char* ldsX = lds; float* ldsA = (float*)(lds + 135168); float* ldsD = (float*)(lds + 139264);
        unsigned char* stg = lds + 143360 + wave * 2304; const int rl = lane >> 2, cc = lane & 3;
        for (int it = blockIdx.x; it < 512; it += G) {
            const int bc = it >> 2, g = it & 3; const size_t row0 = (size_t)bc * 128;
            for (int q = tid; q < 8192; q += 512) { const int r = q >> 6, c16 = q & 63; *(v4u*)(ldsX + r * 1056 + c16 * 16) = *(const v4u*)(XBC + (row0 + r) * XW + g * 512 + c16 * 8); }
            for (int q = tid; q < 1024; q += 512) { const int hh = q >> 7, r = q & 127; ldsA[q] = ACS[(row0 + r) * NH + 8 * g + hh]; ldsD[q] = DT[(row0 + r) * NH + 8 * g + hh]; }
            bf16x8 Cf[4];
            { const bf16* Cg = XBC + (row0 + 16 * wave + li) * XW + 2560 + g * 128 + 8 * gq;
#pragma unroll
              for (int ks = 0; ks < 4; ++ks) Cf[ks] = *(const bf16x8*)(Cg + 32 * ks); }
            f32x4 sc[8];
#pragma unroll
            for (int st = 0; st < 8; ++st) { sc[st] = (f32x4){0.f, 0.f, 0.f, 0.f};
                if (st <= wave) { const bf16* Bg = XBC + (row0 + 16 * st + li) * XW + 2048 + g * 128 + 8 * gq;
#pragma unroll
                    for (int ks = 0; ks < 4; ++ks) { const bf16x8 af = *(const bf16x8*)(Bg + 32 * ks); sc[st] = MFMA16(af, Cf[ks], sc[st]); }
                } }
            __syncthreads();
            const int lrow = 16 * wave + li;
            float ssq = 0.f;
            bool dmask[4];
#pragma unroll
            for (int r = 0; r < 4; ++r) dmask[r] = (4 * gq + r <= li);
#pragma unroll 1
            for (int hh = 0; hh < 8; ++hh) {
                const int h = 8 * g + hh; const unsigned char* xh = ldsX + hh * 128;
                const float* aA = ldsA + hh * 128; const float* aD = ldsD + hh * 128;
                const bf16* prev = STATES + ((size_t)bc * NH + h) * 8192;
                bf16x8 ap[4][4];
#pragma unroll
                for (int pt = 0; pt < 4; ++pt)
#pragma unroll
                    for (int ks = 0; ks < 4; ++ks) ap[pt][ks] = *(const bf16x8*)(prev + (16 * pt + li) * 128 + 32 * ks + 8 * gq);
                v4u* zp0 = (v4u*)(Z + (row0 + 16 * wave + rl) * DI + h * 64 + cc * 16);
                const v4u zv0 = zp0[0], zv1 = zp0[1];
                const float al = aA[lrow];
                f32x4 acc[4], acc2[4];
#pragma unroll
                for (int pt = 0; pt < 4; ++pt) { acc[pt] = (f32x4){0.f, 0.f, 0.f, 0.f}; acc2[pt] = (f32x4){0.f, 0.f, 0.f, 0.f}; }
#pragma unroll
                for (int q = 0; q < 4; ++q) {
                    if (2 * q <= wave) {
                        const f32x4 as0 = *(const f32x4*)(aA + 32 * q + 4 * gq), as1 = *(const f32x4*)(aA + 32 * q + 16 + 4 * gq);
                        const f32x4 dd0 = *(const f32x4*)(aD + 32 * q + 4 * gq), dd1 = *(const f32x4*)(aD + 32 * q + 16 + 4 * gq);
                        float mv[8];
#pragma unroll
                        for (int r = 0; r < 4; ++r) {
                            float v0 = sc[2 * q][r] * (__expf(fminf(al - as0[r], 0.f)) * dd0[r]);
                            float v1 = sc[2 * q + 1][r] * (__expf(fminf(al - as1[r], 0.f)) * dd1[r]);
                            if (2 * q == wave && !dmask[r]) v0 = 0.f;
                            if (2 * q + 1 == wave && !dmask[r]) v1 = 0.f;
                            mv[r] = v0; mv[4 + r] = v1;
                        }
                        v4u mp; mp.x = pk2(mv[0], mv[1]); mp.y = pk2(mv[2], mv[3]); mp.z = pk2(mv[4], mv[5]); mp.w = pk2(mv[6], mv[7]);
                        const bf16x8 Mf = __builtin_bit_cast(bf16x8, mp);
#pragma unroll
                        for (int pt = 0; pt < 4; ++pt) {
                            const bf16x8 ax = cat8(ds_tr(xh + (32 * q + 4 * gq + lr) * 1056 + (16 * pt + 4 * lc) * 2), ds_tr(xh + (32 * q + 16 + 4 * gq + lr) * 1056 + (16 * pt + 4 * lc) * 2));
                            acc[pt] = MFMA16(ax, Mf, acc[pt]);
                        }
                    }
                }
#pragma unroll
                for (int pt = 0; pt < 4; ++pt)
#pragma unroll
                    for (int ks = 0; ks < 4; ++ks) acc2[pt] = MFMA16(ap[pt][ks], Cf[ks], acc2[pt]);
                const float el = __expf(al), Dh = d_skip[h];
#pragma unroll
                for (int pt = 0; pt < 4; ++pt) { const f32x4 yy = acc[pt] + acc2[pt] * el; v2u o; o.x = pk2(yy[0], yy[1]); o.y = pk2(yy[2], yy[3]); *(v2u*)(stg + li * 144 + (16 * pt + 4 * gq) * 2) = o; }
                const v4u ys0 = *(const v4u*)(stg + rl * 144 + cc * 32), ys1 = *(const v4u*)(stg + rl * 144 + cc * 32 + 16);
                const v4u xs0 = *(const v4u*)(xh + (16 * wave + rl) * 1056 + cc * 32), xs1 = *(const v4u*)(xh + (16 * wave + rl) * 1056 + cc * 32 + 16);
                v4u o0, o1;
#pragma unroll
                for (int q = 0; q < 4; ++q) {
                    const float a0 = (bflo(ys0[q]) + Dh * bflo(xs0[q])) * siluf(bflo(zv0[q])), a1 = (bfhi(ys0[q]) + Dh * bfhi(xs0[q])) * siluf(bfhi(zv0[q]));
                    const float b0 = (bflo(ys1[q]) + Dh * bflo(xs1[q])) * siluf(bflo(zv1[q])), b1 = (bfhi(ys1[q]) + Dh * bfhi(xs1[q])) * siluf(bfhi(zv1[q]));
                    ssq += (a0 * a0 + a1 * a1) + (b0 * b0 + b1 * b1);
                    o0[q] = pk2(a0, a1); o1[q] = pk2(b0, b1);
                }
                v4u* zq = zp0; if (DRY(6)) zq = (v4u*)(HALO + ((((row0 + 16 * wave + rl) * DI + h * 64 + cc * 16)) & 0xFFFF0));
                zq[0] = o0; zq[1] = o1;
            }
            ssq += __shfl_xor(ssq, 1); ssq += __shfl_xor(ssq, 2);
            const float rstd = rsqrtf(ssq * (1.f / 512.f) + EPS);
#pragma unroll 2
            for (int hh = 0; hh < 8; ++hh) {
                const int chn = 512 * g + 64 * hh + 16 * cc;
                v4u* zq = (v4u*)(Z + (row0 + 16 * wave + rl) * DI + chn); if (DRY(6)) zq = (v4u*)(HALO + ((((row0 + 16 * wave + rl) * DI + chn)) & 0xFFFF0));
                const v4u y0 = zq[0], y1 = zq[1];
                const f32x4 n0 = *(const f32x4*)(ssd_norm_w + chn), n1 = *(const f32x4*)(ssd_norm_w + chn + 4), n2 = *(const f32x4*)(ssd_norm_w + chn + 8), n3 = *(const f32x4*)(ssd_norm_w + chn + 12);
                v4u o0, o1;
                o0[0] = pk2(bflo(y0[0]) * rstd * n0[0], bfhi(y0[0]) * rstd * n0[1]); o0[1] = pk2(bflo(y0[1]) * rstd * n0[2], bfhi(y0[1]) * rstd * n0[3]);
                o0[2] = pk2(bflo(y0[2]) * rstd * n1[0], bfhi(y0[2]) * rstd * n1[1]); o0[3] = pk2(bflo(y0[3]) * rstd * n1[2], bfhi(y0[3]) * rstd * n1[3]);
                o1[0] = pk2(bflo(y1[0]) * rstd * n2[0], bfhi(y1[0]) * rstd * n2[1]); o1[1] = pk2(bflo(y1[1]) * rstd * n2[2], bfhi(y1[1]) * rstd * n2[3]);
                o1[2] = pk2(bflo(y1[2]) * rstd * n3[0], bfhi(y1[2]) * rstd * n3[1]); o1[3] = pk2(bflo(y1[3]) * rstd * n3[2], bfhi(y1[3]) * rstd * n3[3]);
                zq[0] = o0; zq[1] = o1;
            }
            __syncthreads();
        }
    }
    xcd_barrier(xbar);
    STAMP(8);
    REP(70)
    {
        PHASE_IDS
        pg8::Gemm g{H, Win_t + (size_t)6144 * D, T, 2048, D}; pg8::StaticOrder S; S.init(T, 2048, G, (int)blockIdx.x);
        pg8::EpiMk<1> E{}; E.O0 = GATES; E.ldc = 2048;
        pg8::gemm_phase<pg8::EpiMk<1>, pg8::StaticOrder, true, true>(gl, g, S, E);
        LAS float* scr = (LAS float*)(gl + wave * 16384);
        REP(72)
        for (int it = gw; it < 4096; it += NGW) {
            if (it < 2048) transpose_item(w_up, FF, (it / 128) * 64, (it % 128) * 32, Wup_t, D, (it % 128) * 32, scr, lane);
            else { const int r = it - 2048; transpose_item(w_down, D, (r / 32) * 64, (r % 32) * 32, Wdown_t, FF, (r % 32) * 32, scr, lane); }
        }
    }
    xcd_barrier(xbar);
    STAMP(9);
    REP(71)
    {
        pg8::Gemm g{Z, Wbssd_t, T, D, DI}; pg8::StaticOrder S; S.init(T, D, G, (int)blockIdx.x);
        pg8::EpiMk<3> E{}; E.O0 = MERGED; E.ldc = D; E.G = GATES; E.YP = YPOOL;
        pg8::gemm_phase<pg8::EpiMk<3>, pg8::StaticOrder, true, true>(gl, g, S, E);
    }
    xcd_barrier(xbar);
    STAMP(10);
    REP(8)
    {
        pg8::Gemm g{MERGED, Wout_t, T, D, D}; pg8::StaticOrder S; S.init(T, D, G, (int)blockIdx.x);
        pg8::EpiMk<4> E{}; E.ldc = D; E.X0 = x; E.OF = X1; E.gate = MOD + 2048;
        pg8::gemm_phase<pg8::EpiMk<4>, pg8::StaticOrder, true, true>(gl, g, S, E);
    }
    xcd_barrier(xbar);
    STAMP(11);
    REP(9)
    { PHASE_IDS
    for (int m = gw; m < T; m += NGW) { const float* md = MOD + (m >> 13) * NMOD; norm_mod_row(X1 + (size_t)m * D, norm_mlp_w, md + 4096, md + 3072, H2 + (size_t)m * D, lane); } }
    xcd_barrier(xbar);
    STAMP(12);
    REP(10)
    {
        pg8::Gemm g{H2, Wup_t, T, FF, D}; pg8::StaticOrder S; S.init(T, FF, G, (int)blockIdx.x);
        pg8::EpiMk<5> E{}; E.O0 = UPB; E.ldc = FF;
        pg8::gemm_phase<pg8::EpiMk<5>, pg8::StaticOrder, true, true>(gl, g, S, E);
    }
    xcd_barrier(xbar);
    STAMP(13);
    {
        pg8::Gemm g{UPB, Wdown_t, T, D, FF}; pg8::StaticOrder S; S.init(T, D, G, (int)blockIdx.x);
        pg8::EpiMk<4> E{}; E.ldc = D; E.X0 = X1; E.OF = X1; E.gate = MOD + 5120;
        pg8::gemm_phase<pg8::EpiMk<4>, pg8::StaticOrder, true, true>(gl, g, S, E);
    }
    xcd_barrier(xbar);
    STAMP(14);
    { PHASE_IDS
    for (int m = gw; m < T; m += NGW) {
        f32x4* xr = (f32x4*)(X1 + (size_t)m * D) + lane; f32x4 v[4]; float s = 0.f;
#pragma unroll
        for (int j = 0; j < 4; ++j) { v[j] = xr[64 * j]; s += (v[j].x * v[j].x + v[j].y * v[j].y) + (v[j].z * v[j].z + v[j].w * v[j].w); }
        const float rstd = rsqrtf(wave_sum(s) * (1.f / D) + EPS);
#pragma unroll
        for (int j = 0; j < 4; ++j) xr[64 * j] = v[j] * rstd * ((const f32x4*)norm_final_w)[lane + 64 * j];
    } }
#ifdef TPROBE
    xcd_barrier(xbar);
    STAMP(15);
    if (blockIdx.x == 0) {
        PHASE_IDS
        __syncthreads();
        const float A = (float)(TS[TA_HI] - TS[TA_LO]) * 0.01f, B = (float)(TS[TB_HI] - TS[TB_LO]) * 0.01f;
        if (tid == 0) P.out[0] += A;
        for (int k = 1 + tid; k <= 10000; k += 512) P.out[(size_t)k * 1024] += B;
    }
#endif
}

extern "C" void kernel_launch(void* const* d_in, const int* in_sizes, int n_in, void* d_out, int out_size, void* d_ws, size_t ws_size, hipStream_t stream) {
    static int grid_blocks = 0;
    if (!grid_blocks) {
        int dev = 0, cus = 0, per_cu = 0;
        hipGetDevice(&dev);
        hipDeviceGetAttribute(&cus, hipDeviceAttributeMultiprocessorCount, dev);
        hipFuncSetAttribute((const void*)mk_fwd, hipFuncAttributeMaxDynamicSharedMemorySize, LDS_BYTES);
        hipOccupancyMaxActiveBlocksPerMultiprocessor(&per_cu, (const void*)mk_fwd, 512, LDS_BYTES);
        if (per_cu < 1) { fprintf(stderr, "occupancy query reports %d blocks/CU\n", per_cu); per_cu = 1; }
        grid_blocks = cus * 1;
        if (n_in != 21 || ws_size < 256 * MiB) fprintf(stderr, "kernel_launch: unexpected n_in %d / ws_size %zu\n", n_in, ws_size);
    }
    (void)hipMemsetAsync((char*)d_ws + WS_BAR, 0, 16384, stream);
    Params p{};
    for (int i = 0; i < 21; ++i) p.in[i] = (const float*)d_in[i];
    p.out = (float*)d_out; p.ws = (unsigned char*)d_ws;
    void* args[] = {&p};
    hipError_t e = hipLaunchCooperativeKernel((const void*)mk_fwd, dim3(grid_blocks), dim3(512), args, LDS_BYTES, stream);
    if (e != hipSuccess) fprintf(stderr, "cooperative launch failed: %s (grid %d)\n", hipGetErrorString(e), grid_blocks);
}
```

```cpp
#include <hip/hip_runtime.h>
#include <hip/hip_cooperative_groups.h>
#include <cstdio>
#include <cstdint>
namespace cg = cooperative_groups;
#ifndef DUP_PH
#define DUP_PH -1
#endif
#define DRY(n) (((DUP_PH) == (n)) && rep_ == 0)
#define REP(n) _Pragma("clang loop unroll(disable)") for (int rep_ = 0; rep_ < ((DUP_PH) == (n) ? 2 : 1); ++rep_)
namespace pg8 {
#define PG8_LAS __attribute__((address_space(3)))
typedef unsigned short bf16_t;
typedef short bf16x8 __attribute__((ext_vector_type(8)));
typedef float f32x4 __attribute__((ext_vector_type(4)));
typedef unsigned u32x4 __attribute__((ext_vector_type(4)));
constexpr int BM = 256, BK = 64, HALF = 128, HTB = HALF * BK * 2  , STAGE_BYTES = 8 * HTB, NXCD = 8, WGM = 8;

__host__ __device__ __forceinline__ int lds_byte(int r, int c) { const int st = (r >> 4) * 2 + (c >> 5), rr = r & 15, cc = c & 31, ob = rr * 64 + cc * 2; return st * 1024 + (ob ^ (((ob >> 9) & 1) << 5)); }
__host__ __device__ __forceinline__ void stage_rc(int b, int& R, int& C) { const int st = b / 1024, sb = b % 1024, swz = sb ^ (((sb >> 9) & 1) << 5); R = (st >> 1) * 16 + swz / 64; C = (st & 1) * 32 + (swz % 64) / 2; }
__host__ __device__ __forceinline__ int perm32(int rho) { const int n = rho >> 4, i = rho & 15; return 8 * (i >> 2) + 4 * n + (i & 3); }

struct Unit { int pm, pn; };
struct Gemm { const bf16_t* A; const bf16_t* Bt; int M, N, K; };

struct StaticOrder {
    int nM, nN, nwg, G, c;
    __host__ __device__ void init(int M, int N, int G_, int c_) { nM = M / BM; nN = N / BM; nwg = nM * nN; G = G_; c = c_; }
    __host__ __device__ bool next(int i, Unit& u) const {
        const long L = (long)i * G + c; if (L >= nwg) return false;
        int wgid = (int)L; { const int q = nwg / NXCD, r = nwg % NXCD, xcd = wgid % NXCD, off = wgid / NXCD; wgid = (xcd < r ? xcd * (q + 1) : r * (q + 1) + (xcd - r) * q) + off; }
        const int nig = WGM * nN, gid = wgid / nig, fm = gid * WGM, gsz = (nM - fm) < WGM ? (nM - fm) : WGM;
        u.pm = fm + ((wgid % nig) % gsz); u.pn = (wgid % nig) / gsz; return true;
    }
    __device__ __forceinline__ void a_ready(const Unit&) const {}
    __device__ __forceinline__ void done(const Unit&) const {}
};

typedef float f32x2c __attribute__((ext_vector_type(2))); typedef __bf16 bf16x2c __attribute__((ext_vector_type(2)));
__device__ __forceinline__ unsigned cvt_pk_bf16(float lo, float hi) { f32x2c v = {lo, hi}; bf16x2c b = __builtin_convertvector(v, bf16x2c); return __builtin_bit_cast(unsigned, b); }
template <int MODE> struct EpiMk {
    static constexpr bool PERM = true, AFTER_DRAIN = false;
    bf16_t* O0; bf16_t* O1; bf16_t* O2; bf16_t* halo; int ldc;
    const bf16_t* G; const bf16_t* YP; const float* X0; float* OF; const float* gate;
    __device__ __forceinline__ void operator()(const f32x4 (&acc)[2][2][4][2], const Unit& u, int wr, int wc, int fr, int fq) const {
        const int row0 = u.pm * BM + wr * 64 + fr;
        int colt = u.pn * BM; bf16_t* base = O0; int ld = ldc; bool dohalo = false;
        if constexpr (MODE == 0) {
            if (u.pn < 8) { base = O0; ld = 2048; }
            else if (u.pn < 20) { base = O1; ld = 3072; colt -= 2048; dohalo = true; }
            else { base = O2; ld = 1024; colt -= 5120; }
        }
        const int col0 = colt + wc * 32 + 8 * fq;
#pragma unroll
        for (int ai = 0; ai < 2; ++ai)
#pragma unroll
            for (int m = 0; m < 4; ++m) {
                const int row = row0 + ai * HALF + m * 16;
#pragma unroll
                for (int bj = 0; bj < 2; ++bj) {
                    const int col = col0 + bj * HALF;
                    f32x4 v0 = acc[ai][bj][m][0], v1 = acc[ai][bj][m][1];
                    if constexpr (MODE == 4) {
                        const float* gp = gate + (row >= 8192 ? 6144 : 0) + col;
                        const f32x4 g0 = *(const f32x4*)gp, g1 = *(const f32x4*)(gp + 4);
                        const float* xp = X0 + (size_t)row * ld + col;
                        const f32x4 x0 = *(const f32x4*)xp, x1 = *(const f32x4*)(xp + 4);
                        float* op = OF + (size_t)row * ld + col;
                        *(f32x4*)op = x0 + g0 * v0; *(f32x4*)(op + 4) = x1 + g1 * v1;
                    } else {
                        if constexpr (MODE == 1) {
#pragma unroll
                            for (int e = 0; e < 4; ++e) { v0[e] = __builtin_amdgcn_rcpf(1.f + __expf(-v0[e])); v1[e] = __builtin_amdgcn_rcpf(1.f + __expf(-v1[e])); }
                        }
                        if constexpr (MODE == 5) {
#pragma unroll
                            for (int e = 0; e < 4; ++e) { float a = fmaxf(v0[e], 0.f), b = fmaxf(v1[e], 0.f); v0[e] = a * a; v1[e] = b * b; }
                        }
                        if constexpr (MODE == 3) {
                            const u32x4 gs = *(const u32x4*)(G + (size_t)row * 2048 + col);
                            const u32x4 gq = *(const u32x4*)(G + (size_t)row * 2048 + 1024 + col);
                            const u32x4 yp = *(const u32x4*)(YP + (size_t)row * 1024 + col);
#pragma unroll
                            for (int e = 0; e < 2; ++e) {
                                v0[2 * e] = __builtin_bit_cast(float, gs[e] << 16) * v0[2 * e] + __builtin_bit_cast(float, gq[e] << 16) * __builtin_bit_cast(float, yp[e] << 16);
                                v0[2 * e + 1] = __builtin_bit_cast(float, gs[e] & 0xffff0000u) * v0[2 * e + 1] + __builtin_bit_cast(float, gq[e] & 0xffff0000u) * __builtin_bit_cast(float, yp[e] & 0xffff0000u);
                                v1[2 * e] = __builtin_bit_cast(float, gs[2 + e] << 16) * v1[2 * e] + __builtin_bit_cast(float, gq[2 + e] << 16) * __builtin_bit_cast(float, yp[2 + e] << 16);
                                v1[2 * e + 1] = __builtin_bit_cast(float, gs[2 + e] & 0xffff0000u) * v1[2 * e + 1] + __builtin_bit_cast(float, gq[2 + e] & 0xffff0000u) * __builtin_bit_cast(float, yp[2 + e] & 0xffff0000u);
                            }
                        }
                        u32x4 w; w.x = cvt_pk_bf16(v0[0], v0[1]); w.y = cvt_pk_bf16(v0[2], v0[3]); w.z = cvt_pk_bf16(v1[0], v1[1]); w.w = cvt_pk_bf16(v1[2], v1[3]);
                        *(u32x4*)(base + (size_t)row * ld + col) = w;
                        if constexpr (MODE == 0) {
                            if (dohalo && (row & 127) >= 125) *(u32x4*)(halo + ((size_t)(row >> 7) * 3 + ((row & 127) - 125)) * 3072 + col) = w;
                        }
                    }
                }
            }
    }
};


template <class Epi, class Sched, bool ALIGN_EPI = false, bool SP2 = false>
__device__ __forceinline__ void gemm_phase(PG8_LAS unsigned char* lds, const Gemm g, const Sched& S, const Epi& E) {
    const int tid = threadIdx.x, wid = __builtin_amdgcn_readfirstlane(tid >> 6), lane = tid & 63, wr = wid >> 2, wc = wid & 3, fr = lane & 15, fq = lane >> 4;
    const int K = g.K, nt = K / BK;
    unsigned voffA[2], voffB[2];
#pragma unroll
    for (int i = 0; i < 2; ++i) { int R, C; stage_rc(tid * 16 + i * 8192, R, C); const int Rb = Epi::PERM ? ((R & ~31) + perm32(R & 31)) : R;
        voffA[i] = (unsigned)(R * K + C) * 2u; voffB[i] = (unsigned)(Rb * K + C) * 2u; }
    const size_t kstep = (size_t)(BK * 2);
    const size_t hstep = (size_t)HALF * K * 2;
    const size_t tstep = 2 * hstep;
    const unsigned ldsw = (unsigned)wid * 1024u;
    const int aoff = lds_byte(wr * 64 + fr, fq * 8), boff = lds_byte(wc * 32 + fr, fq * 8);
#define PG8_SA(b, h) (((b) * 2 + (h)) * HTB)
#define PG8_SB(b, h) ((4 + (b) * 2 + (h)) * HTB)
#define PG8_STAGE(bufoff, gbase, voff) do { _Pragma("unroll") for (int _i = 0; _i < 2; ++_i) \
        __builtin_amdgcn_global_load_lds((const unsigned*)((const char*)(gbase) + (voff)[_i]), (PG8_LAS unsigned*)(lds + (bufoff) + ldsw + _i * 8192), 16, 0, 0); } while (0)
#define PG8_LDA(dst, b, h) do { _Pragma("unroll") for (int m = 0; m < 4; ++m) _Pragma("unroll") for (int k = 0; k < 2; ++k) dst[m][k] = *(const PG8_LAS bf16x8*)(lds + PG8_SA(b, h) + aoff + m * 2048 + k * 1024); } while (0)
#define PG8_LDB(dst, b, h) do { _Pragma("unroll") for (int n = 0; n < 2; ++n) _Pragma("unroll") for (int k = 0; k < 2; ++k) dst[n][k] = *(const PG8_LAS bf16x8*)(lds + PG8_SB(b, h) + boff + n * 2048 + k * 1024); } while (0)
#define PG8_MMA(ai, bj, At, Bt) do { __builtin_amdgcn_s_setprio(1); _Pragma("unroll") for (int m = 0; m < 4; ++m) _Pragma("unroll") for (int n = 0; n < 2; ++n) _Pragma("unroll") for (int k = 0; k < 2; ++k) \
        acc[ai][bj][m][n] = __builtin_amdgcn_mfma_f32_16x16x32_bf16(Bt[n][k], At[m][k], acc[ai][bj][m][n], 0, 0, 0); __builtin_amdgcn_s_setprio(0); } while (0)
#define PG8_WAIT_V(n) asm volatile("s_waitcnt vmcnt(" #n ")" ::: "memory")
#define PG8_WAIT_L(n) asm volatile("s_waitcnt lgkmcnt(" #n ")" ::: "memory")
#define PG8_BAR __builtin_amdgcn_s_barrier()
#define PG8_SCHED __builtin_amdgcn_sched_barrier(0)
    Unit cur, nxt; int ui = 0;
    if (!S.next(0, cur)) return;
    f32x4 acc[2][2][4][2];
#pragma unroll
    for (int a = 0; a < 2; ++a)
#pragma unroll
        for (int b = 0; b < 2; ++b)
#pragma unroll
            for (int m = 0; m < 4; ++m)
#pragma unroll
                for (int n = 0; n < 2; ++n) acc[a][b][m][n] = (f32x4){0.f, 0.f, 0.f, 0.f};
    bf16x8 At[4][2], B0[2][2], B1[2][2];
    const char* cA = (const char*)g.A + (size_t)cur.pm * tstep; const char* cB = (const char*)g.Bt + (size_t)cur.pn * tstep;
    S.a_ready(cur);
    if constexpr (SP2) {
        PG8_STAGE(PG8_SB(0, 0), cB, voffB); PG8_STAGE(PG8_SB(0, 1), cB + hstep, voffB); PG8_STAGE(PG8_SA(0, 0), cA, voffA); PG8_STAGE(PG8_SA(0, 1), cA + hstep, voffA);
        if (wr == 1) PG8_BAR;
        PG8_WAIT_V(2); PG8_BAR;
        PG8_STAGE(PG8_SB(1, 0), cB + kstep, voffB); PG8_STAGE(PG8_SA(1, 0), cA + kstep, voffA); PG8_STAGE(PG8_SB(1, 1), cB + hstep + kstep, voffB);
        PG8_WAIT_V(6); PG8_BAR;
    } else {
        PG8_STAGE(PG8_SB(0, 0), cB, voffB); PG8_STAGE(PG8_SA(0, 0), cA, voffA); PG8_STAGE(PG8_SB(0, 1), cB + hstep, voffB); PG8_STAGE(PG8_SA(0, 1), cA + hstep, voffA);
        if (wr == 1) PG8_BAR;
        PG8_WAIT_V(4); PG8_BAR;
        PG8_STAGE(PG8_SB(1, 0), cB + kstep, voffB); PG8_STAGE(PG8_SA(1, 0), cA + kstep, voffA); PG8_STAGE(PG8_SB(1, 1), cB + hstep + kstep, voffB);
        PG8_WAIT_V(6); PG8_BAR;
    }
    for (;;) {
        const bool has_next = S.next(ui + 1, nxt);
        const char* nA = has_next ? (const char*)g.A + (size_t)nxt.pm * tstep : cA; const char* nB = has_next ? (const char*)g.Bt + (size_t)nxt.pn * tstep : cB;
        for (int t = 0; t < nt; t += 2) {
            const bool last = (t == nt - 2);
            const char* a1 = cA + (size_t)(t + 1) * kstep;
            const char* a2 = last ? nA : cA + (size_t)(t + 2) * kstep; const char* b2 = last ? nB : cB + (size_t)(t + 2) * kstep;
            const char* a3 = a2 + kstep; const char* b3 = b2 + kstep;
            if (last && has_next) S.a_ready(nxt);
            if constexpr (SP2) {
            PG8_LDB(B0, 0, 0); PG8_LDB(B1, 0, 1); PG8_SCHED; PG8_LDA(At, 0, 0); PG8_STAGE(PG8_SA(1, 1), a1 + hstep, voffA);
            PG8_WAIT_V(8); PG8_WAIT_L(0); PG8_BAR; PG8_MMA(0, 0, At, B0); PG8_MMA(0, 1, At, B1); PG8_BAR; PG8_SCHED;
            PG8_LDA(At, 0, 1); PG8_STAGE(PG8_SB(0, 0), b2, voffB); PG8_STAGE(PG8_SB(0, 1), b2 + hstep, voffB); PG8_STAGE(PG8_SA(0, 0), a2, voffA);
            PG8_WAIT_V(8); PG8_WAIT_L(0); PG8_BAR; PG8_MMA(1, 0, At, B0); PG8_MMA(1, 1, At, B1); PG8_BAR; PG8_SCHED;
            PG8_LDB(B0, 1, 0); PG8_LDB(B1, 1, 1); PG8_SCHED; PG8_LDA(At, 1, 0); PG8_STAGE(PG8_SA(0, 1), a2 + hstep, voffA);
            PG8_WAIT_V(8); PG8_WAIT_L(0); PG8_BAR; PG8_MMA(0, 0, At, B0); PG8_MMA(0, 1, At, B1); PG8_BAR; PG8_SCHED;
            PG8_LDA(At, 1, 1); PG8_STAGE(PG8_SB(1, 0), b3, voffB); PG8_STAGE(PG8_SB(1, 1), b3 + hstep, voffB); PG8_STAGE(PG8_SA(1, 0), a3, voffA);
            PG8_WAIT_V(8); PG8_WAIT_L(0); PG8_BAR; PG8_MMA(1, 0, At, B0); PG8_MMA(1, 1, At, B1); PG8_BAR; PG8_SCHED;
            } else {
            PG8_LDB(B0, 0, 0); PG8_SCHED; PG8_LDA(At, 0, 0); PG8_STAGE(PG8_SA(1, 1), a1 + hstep, voffA);
            PG8_WAIT_L(8); PG8_BAR; PG8_WAIT_L(0); PG8_MMA(0, 0, At, B0); PG8_BAR; PG8_SCHED;
            PG8_LDB(B1, 0, 1); PG8_STAGE(PG8_SB(0, 0), b2, voffB);
            PG8_BAR; PG8_WAIT_L(0); PG8_MMA(0, 1, At, B1); PG8_BAR;
            PG8_LDA(At, 0, 1); PG8_STAGE(PG8_SA(0, 0), a2, voffA);
            PG8_BAR; PG8_WAIT_L(0); PG8_MMA(1, 0, At, B0); PG8_BAR; PG8_SCHED;
            PG8_STAGE(PG8_SB(0, 1), b2 + hstep, voffB);
            PG8_WAIT_V(6); PG8_BAR; PG8_MMA(1, 1, At, B1); PG8_BAR;
            PG8_LDB(B0, 1, 0); PG8_SCHED; PG8_LDA(At, 1, 0); PG8_STAGE(PG8_SA(0, 1), a2 + hstep, voffA);
            PG8_WAIT_L(8); PG8_BAR; PG8_WAIT_L(0); PG8_MMA(0, 0, At, B0); PG8_BAR; PG8_SCHED;
            PG8_LDB(B1, 1, 1); PG8_STAGE(PG8_SB(1, 0), b3, voffB);
            PG8_BAR; PG8_WAIT_L(0); PG8_MMA(0, 1, At, B1); PG8_BAR;
            PG8_LDA(At, 1, 1); PG8_STAGE(PG8_SA(1, 0), a3, voffA);
            PG8_BAR; PG8_WAIT_L(0); PG8_MMA(1, 0, At, B0); PG8_BAR; PG8_SCHED;
            PG8_STAGE(PG8_SB(1, 1), b3 + hstep, voffB);
            PG8_WAIT_V(6); PG8_BAR; PG8_MMA(1, 1, At, B1); PG8_BAR;
            }
        }
        if constexpr (ALIGN_EPI) { if (wr == 0) PG8_BAR; }
        if constexpr (!Epi::AFTER_DRAIN) { E(acc, cur, wr, wc, fr, fq); S.done(cur); }
        if (!has_next) break;
#pragma unroll
        for (int a = 0; a < 2; ++a)
#pragma unroll
            for (int b = 0; b < 2; ++b)
#pragma unroll
                for (int m = 0; m < 4; ++m)
#pragma unroll
                    for (int n = 0; n < 2; ++n) acc[a][b][m][n] = (f32x4){0.f, 0.f, 0.f, 0.f};
        cur = nxt; cA = nA; cB = nB; ++ui;
        if constexpr (ALIGN_EPI) { if (wr == 1) PG8_BAR; }
    }
    PG8_WAIT_V(0);
    if constexpr (!ALIGN_EPI) { if (wr == 0) PG8_BAR; }
    PG8_BAR;
    if constexpr (Epi::AFTER_DRAIN) { E.fused(acc, cur, wr, wc, fr, fq, lds, wid, lane); S.done(cur); }
#undef PG8_SA
#undef PG8_SB
#undef PG8_STAGE
#undef PG8_LDA
#undef PG8_LDB
#undef PG8_MMA
#undef PG8_WAIT_V
#undef PG8_WAIT_L
#undef PG8_BAR
#undef PG8_SCHED
}
}
#define LAS __attribute__((address_space(3)))
typedef unsigned short bf16;
typedef unsigned v4u __attribute__((ext_vector_type(4)));
typedef unsigned v2u __attribute__((ext_vector_type(2)));
typedef float f32x4 __attribute__((ext_vector_type(4)));
typedef short bf16x8 __attribute__((ext_vector_type(8)));
typedef short s16x4 __attribute__((ext_vector_type(4)));
typedef short v4i16_t __attribute__((ext_vector_type(4)));

constexpr int T = 16384, SEQ = 8192, D = 1024, DI = 2048, XW = 3072, FF = 4096, NH = 32, NMOD = 6144, INC = 8224;
constexpr float EPS = 1e-5f;
constexpr size_t MiB = 1u << 20;
constexpr size_t WS_WIN = 0, WS_WBSSD = 16 * MiB, WS_WPP = 20 * MiB, WS_WOUT = 22 * MiB, WS_WDT = 24 * MiB, WS_MOD = 24 * MiB + 65536;
constexpr size_t WS_DT = 25 * MiB, WS_ACS = 27 * MiB, WS_HALO = 29 * MiB;
constexpr size_t WS_XBC = 32 * MiB, WS_GATES = 32 * MiB, WS_UP = 32 * MiB;
constexpr size_t WS_H = 128 * MiB, WS_MERGED = 128 * MiB;
constexpr size_t WS_UPOOL = 160 * MiB, WS_YPOOL = 160 * MiB, WS_H2 = 160 * MiB;
constexpr size_t WS_POOLED = 192 * MiB, WS_STATES = 192 * MiB, WS_WUP = 192 * MiB, WS_WDOWN = 200 * MiB;
constexpr int LDS_BYTES = 163840;

typedef float f32x2_t __attribute__((ext_vector_type(2))); typedef __bf16 bf16x2_t __attribute__((ext_vector_type(2)));
__device__ __forceinline__ unsigned pk2(float lo, float hi) { f32x2_t v = {lo, hi}; bf16x2_t b = __builtin_convertvector(v, bf16x2_t); return __builtin_bit_cast(unsigned, b); }
__device__ __forceinline__ float bflo(unsigned u) { return __builtin_bit_cast(float, u << 16); }
__device__ __forceinline__ float bfhi(unsigned u) { return __builtin_bit_cast(float, u & 0xffff0000u); }
__device__ __forceinline__ float wave_sum(float v) {
#pragma unroll
    for (int o = 1; o < 64; o <<= 1) v += __shfl_xor(v, o);
    return v;
}
__device__ __forceinline__ float siluf(float v) { return v * __builtin_amdgcn_rcpf(1.f + __expf(-v)); }
__device__ __forceinline__ s16x4 ds_tr(const unsigned char* p) { return __builtin_bit_cast(s16x4, __builtin_amdgcn_ds_read_tr16_b64_v4i16((LAS v4i16_t*)p)); }
__device__ __forceinline__ bf16x8 cat8(s16x4 a, s16x4 b) { return __builtin_shufflevector(a, b, 0, 1, 2, 3, 4, 5, 6, 7); }
#define MFMA16(a, b, c) __builtin_amdgcn_mfma_f32_16x16x32_bf16((a), (b), (c), 0, 0, 0)

__device__ __forceinline__ void transpose_item(const float* W, int ldw, int k0, int c0, bf16* WT, int K, int drow0, LAS float* scr, int lane) {
#pragma unroll 8
    for (int i = 0; i < 32; ++i) { const int kk = 2 * i + (lane >> 5); scr[kk * 33 + (lane & 31)] = W[(size_t)(k0 + kk) * ldw + c0 + (lane & 31)]; }
    asm volatile("s_waitcnt lgkmcnt(0)" ::: "memory");
    const int c = lane & 7;
#pragma unroll
    for (int j = 0; j < 4; ++j) { const int n = (lane >> 3) + 8 * j; const LAS float* s = scr + (8 * c) * 33 + n;
        v4u o; o.x = pk2(s[0 * 33], s[1 * 33]); o.y = pk2(s[2 * 33], s[3 * 33]); o.z = pk2(s[4 * 33], s[5 * 33]); o.w = pk2(s[6 * 33], s[7 * 33]);
        *(v4u*)(WT + (size_t)(drow0 + n) * K + k0 + 8 * c) = o; }
    asm volatile("s_waitcnt lgkmcnt(0)" ::: "memory");
}

__device__ __forceinline__ void norm_mod_row(const float* xrow, const float* w, const float* scale, const float* shift, bf16* orow, int lane) {
    const f32x4* xr = (const f32x4*)xrow + lane;
    f32x4 v[4]; float s = 0.f;
#pragma unroll
    for (int j = 0; j < 4; ++j) { v[j] = xr[64 * j]; s += (v[j].x * v[j].x + v[j].y * v[j].y) + (v[j].z * v[j].z + v[j].w * v[j].w); }
    const float rstd = rsqrtf(wave_sum(s) * (1.f / D) + EPS);
    v2u* o8 = (v2u*)orow + lane;
#pragma unroll
    for (int j = 0; j < 4; ++j) {
        const f32x4 ww = ((const f32x4*)w)[lane + 64 * j], sc = ((const f32x4*)scale)[lane + 64 * j], sh = ((const f32x4*)shift)[lane + 64 * j];
        f32x4 r = v[j] * rstd * ww * (sc + 1.f) + sh;
        v2u o; o.x = pk2(r.x, r.y); o.y = pk2(r.z, r.w); o8[64 * j] = o;
    }
}

#define XB_TMO      128
#define XB_XCNT(j)  (256  + 64 * (j))
#define XB_XSUB(j)  (1280 + 64 * (j))
#define XB_XGEN(j)  (2304 + 64 * (j))
#define XB_TOP      3328
#define XB_TOPGEN   3392
#define XCD_BAR_WORDS 3456
#define XB_SPIN_CAP (1u << 18)

__device__ __forceinline__ unsigned xb_ld(unsigned* p)              { return __hip_atomic_load(p, __ATOMIC_RELAXED, __HIP_MEMORY_SCOPE_AGENT); }
__device__ __forceinline__ unsigned xb_add(unsigned* p, unsigned v) { return __hip_atomic_fetch_add(p, v, __ATOMIC_RELAXED, __HIP_MEMORY_SCOPE_AGENT); }
__device__ __forceinline__ unsigned xb_xcc_id() { return (unsigned)__builtin_amdgcn_s_getreg((3 << 11) | 20) & 0xFu; }
#define XB_SPIN(cond, bar) do { unsigned _sp = 0; while (cond) { __builtin_amdgcn_s_sleep(1); \
    if ((++_sp & 255u) == 0u) { if (xb_ld(&(bar)[XB_TMO])) break; if (_sp > XB_SPIN_CAP) { atomicAdd(&(bar)[XB_TMO], 1u); break; } } } } while (0)

struct XcdBarrier {
    unsigned* bar; unsigned x;
    volatile LAS unsigned* st;
};

__device__ __forceinline__ XcdBarrier xcd_barrier_post(unsigned* bar, volatile LAS unsigned* st) {
    XcdBarrier b; b.bar = bar; b.x = xb_xcc_id(); b.st = st;
    if (threadIdx.x == 0) (void)xb_add(&bar[XB_XCNT(b.x)], 1u);
    return b;
}
__device__ __forceinline__ void xcd_barrier_complete(unsigned* bar, unsigned x, unsigned& nloc, unsigned& nx) {
    const unsigned G = gridDim.x * gridDim.y * gridDim.z;
    unsigned sum, cnt, mine, sp = 0u;
    for (;;) {
        sum = 0u; cnt = 0u; mine = 0u;
#pragma unroll
        for (unsigned j = 0; j < 16; ++j) { const unsigned c = xb_ld(&bar[XB_XCNT(j)]); sum += c; cnt += (c > 0u) ? 1u : 0u; mine = (j == x) ? c : mine; }
        if (sum == G) break;
        __builtin_amdgcn_s_sleep(1);
        if ((++sp & 255u) == 0u) { if (xb_ld(&bar[XB_TMO])) break; if (sp > XB_SPIN_CAP) { atomicAdd(&bar[XB_TMO], 1u); break; } }
    }
    nloc = mine > 0u ? mine : 1u; nx = cnt > 0u ? cnt : 1u;
}

__device__ __forceinline__ void xcd_barrier(const XcdBarrier& b) {
    asm volatile("s_waitcnt vmcnt(0)" ::: "memory");
    __syncthreads();
    if (threadIdx.x == 0) {
        unsigned* bar = b.bar;
        __builtin_amdgcn_s_waitcnt(0);
        unsigned nloc = b.st[0], nx = b.st[1];
        if (nloc == 0u) { xcd_barrier_complete(bar, b.x, nloc, nx); b.st[0] = nloc; b.st[1] = nx; }
        const unsigned old = xb_add(&bar[XB_XSUB(b.x)], 1u);
        const unsigned gen = old / nloc;
        if (old + 1u == (gen + 1u) * nloc) {
            __builtin_amdgcn_fence(__ATOMIC_RELEASE, "agent");
            asm volatile("s_waitcnt vmcnt(0)" ::: "memory");
            const unsigned og = xb_add(&bar[XB_TOP], 1u);
            const unsigned tg = og / nx;
            if (og + 1u == (tg + 1u) * nx) xb_add(&bar[XB_TOPGEN], 1u);
            else XB_SPIN(xb_ld(&bar[XB_TOPGEN]) == tg, bar);
            __builtin_amdgcn_fence(__ATOMIC_ACQUIRE, "agent");
            xb_add(&bar[XB_XGEN(b.x)], 1u);
            asm volatile("s_waitcnt vmcnt(0)" ::: "memory");
        } else {
            XB_SPIN(xb_ld(&bar[XB_XGEN(b.x)]) == gen, bar);
            __builtin_amdgcn_fence(__ATOMIC_ACQUIRE, "agent");
            asm volatile("s_waitcnt vmcnt(0)" ::: "memory");
        }
    }
    __syncthreads();
}

constexpr size_t WS_BAR = 24 * MiB + 131072;
struct Params { const float* in[21]; float* out; unsigned char* ws; };

__global__ void __launch_bounds__(512, 2) mk_fwd(Params P) {
    extern __shared__ __attribute__((aligned(16))) unsigned char lds[];
    cg::grid_group grid = cg::this_grid();
#define PHASE_IDS int tid = threadIdx.x; asm volatile("" : "+v"(tid)); const int lane = tid & 63, wave = __builtin_amdgcn_readfirstlane(tid >> 6), gw = blockIdx.x * 8 + wave; (void)lane; (void)wave; (void)gw;
    const int G = gridDim.x, NGW = G * 8;
    unsigned char* ws = P.ws;
    const float* x = P.in[0]; const float* cvec = P.in[1]; const float* w_ada = P.in[2]; const float* b_ada = P.in[3]; const float* norm_mix_w = P.in[4];
    const float* w_in = P.in[5]; const float* conv_w = P.in[6]; const float* conv_b = P.in[7]; const float* dt_bias = P.in[8]; const float* a_log = P.in[9];
    const float* d_skip = P.in[10]; const float* ssd_norm_w = P.in[11]; const float* w_bssd = P.in[12]; const float* pool_w = P.in[13]; const float* pool_scale = P.in[14];
    const float* w_bpool = P.in[15]; const float* w_out = P.in[16]; const float* norm_mlp_w = P.in[17]; const float* w_up = P.in[18]; const float* w_down = P.in[19];
    const float* norm_final_w = P.in[20];
    bf16* Win_t = (bf16*)(ws + WS_WIN); bf16* Wbssd_t = (bf16*)(ws + WS_WBSSD); bf16* Wpp_t = (bf16*)(ws + WS_WPP); bf16* Wout_t = (bf16*)(ws + WS_WOUT);
    bf16* Wdt_t = (bf16*)(ws + WS_WDT); float* MOD = (float*)(ws + WS_MOD); float* DT = (float*)(ws + WS_DT); float* ACS = (float*)(ws + WS_ACS);
    bf16* HALO = (bf16*)(ws + WS_HALO); bf16* XBC = (bf16*)(ws + WS_XBC); bf16* GATES = (bf16*)(ws + WS_GATES); bf16* UPB = (bf16*)(ws + WS_UP);
    bf16* H = (bf16*)(ws + WS_H); bf16* MERGED = (bf16*)(ws + WS_MERGED); bf16* UPOOL = (bf16*)(ws + WS_UPOOL); bf16* YPOOL = (bf16*)(ws + WS_YPOOL);
    bf16* H2 = (bf16*)(ws + WS_H2); bf16* POOLED = (bf16*)(ws + WS_POOLED); bf16* STATES = (bf16*)(ws + WS_STATES); bf16* Wup_t = (bf16*)(ws + WS_WUP);
    bf16* Wdown_t = (bf16*)(ws + WS_WDOWN);
    bf16* Z = (bf16*)P.out;
    float* X1 = P.out;
    LAS unsigned char* gl = (LAS unsigned char*)lds;
    volatile LAS unsigned* xst = (volatile LAS unsigned*)(gl + LDS_BYTES - 16);
    if (threadIdx.x < 4) xst[threadIdx.x] = 0u;
    __syncthreads();
    const XcdBarrier xbar = xcd_barrier_post((unsigned*)(P.ws + WS_BAR), xst);
    if (P.ws == nullptr) grid.sync();
#ifdef TPROBE
    unsigned long long* TS = (unsigned long long*)(ws + 24 * MiB + 131072);
#define STAMP(k) do { if (blockIdx.x == 0 && threadIdx.x == 0) TS[k] = __builtin_amdgcn_s_memrealtime(); } while (0)
#else
#define STAMP(k) do {} while (0)
#endif
    STAMP(0);

    REP(0)
    {
        PHASE_IDS
        LAS float* red = (LAS float*)gl;
        for (int it = blockIdx.x; it < 192; it += G) {
            const int j = it * 32 + (lane & 31), kb = wave * 128 + (lane >> 5) * 64; float a0 = 0.f, a1 = 0.f;
#pragma unroll 16
            for (int k = kb; k < kb + 64; ++k) { const float w = w_ada[(size_t)k * NMOD + j]; a0 += siluf(cvec[k]) * w; a1 += siluf(cvec[1024 + k]) * w; }
            red[(wave * 2 + (lane >> 5)) * 64 + (lane & 31)] = a0; red[(wave * 2 + (lane >> 5)) * 64 + 32 + (lane & 31)] = a1; __syncthreads();
            if (tid < 64) { float s = 0.f;
#pragma unroll
                for (int q = 0; q < 16; ++q) s += red[q * 64 + tid];
                const int jj = it * 32 + (tid & 31); MOD[(tid >> 5) * NMOD + jj] = s + b_ada[jj]; }
            __syncthreads();
        }
        LAS float* scr = (LAS float*)(gl + wave * 16384);
        constexpr int I_IN = 16 * 257, I_BS = 32 * 32, I_O = 16 * 32;
        for (int it = gw; it < I_IN + I_BS + I_O; it += NGW) {
            int r = it;
            if (r < I_IN) { const int kb = r / 257, nb = r % 257; const int c0 = nb * 32;
                if (nb == 160) transpose_item(w_in, INC, kb * 64, c0, Wdt_t, D, 0, scr, lane);
                else transpose_item(w_in, INC, kb * 64, c0, Win_t, D, nb < 160 ? c0 : c0 - 32, scr, lane);
                continue; } r -= I_IN;
            if (r < I_BS) { transpose_item(w_bssd, D, (r / 32) * 64, (r % 32) * 32, Wbssd_t, DI, (r % 32) * 32, scr, lane); continue; } r -= I_BS;
            transpose_item(w_out, D, (r / 32) * 64, (r % 32) * 32, Wout_t, D, (r % 32) * 32, scr, lane);
        }
        for (int e = blockIdx.x * 512 + tid; e < 65536; e += G * 512) {
            const int nq = e & 255, kq = __builtin_amdgcn_readfirstlane(e >> 8), k0 = 4 * kq, n0 = 4 * nq, g = k0 >> 8;
            const float* pw = pool_w + (size_t)k0 * 256; const float* ps = pool_scale + g * 256; const float* wb = w_bpool + (size_t)g * 256 * D + n0;
            f32x4 acc4[4];
#pragma unroll
            for (int i = 0; i < 4; ++i) acc4[i] = (f32x4){0.f, 0.f, 0.f, 0.f};
#pragma unroll 8
            for (int j = 0; j < 256; ++j) { const f32x4 bv = *(const f32x4*)(wb + (size_t)j * D); const float sj = ps[j];
#pragma unroll
                for (int i = 0; i < 4; ++i) acc4[i] += bv * (pw[i * 256 + j] * sj); }
#pragma unroll
            for (int c = 0; c < 4; ++c) { v2u o; o.x = pk2(acc4[0][c], acc4[1][c]); o.y = pk2(acc4[2][c], acc4[3][c]); *(v2u*)(Wpp_t + (size_t)(n0 + c) * D + k0) = o; }
        }
    }
    xcd_barrier(xbar);
    STAMP(1);
    REP(1)
    { PHASE_IDS
    for (int m = gw; m < T; m += NGW) { const float* md = MOD + (m >> 13) * NMOD; norm_mod_row(x + (size_t)m * D, norm_mix_w, md + 1024, md, H + (size_t)m * D, lane); } }
    xcd_barrier(xbar);
    STAMP(2);
    REP(2)
    {
        PHASE_IDS
        pg8::Gemm g{H, Win_t, T, 6144, D}; pg8::StaticOrder S; S.init(T, 6144, G, (int)blockIdx.x);
        pg8::EpiMk<0> E{}; E.O0 = Z; E.O1 = XBC; E.O2 = UPOOL; E.halo = HALO; E.ldc = 0;
        pg8::gemm_phase<pg8::EpiMk<0>, pg8::StaticOrder, true, true>(gl, g, S, E);
        const int gq = lane >> 4, i = lane & 15;
        REP(21)
        for (int it = gw; it < T / 16; it += NGW) {
            const int r0 = it * 16; f32x4 a0 = {0.f, 0.f, 0.f, 0.f}, a1 = {0.f, 0.f, 0.f, 0.f};
#pragma unroll 4
            for (int ks = 0; ks < 32; ++ks) {
                const bf16x8 af = *(const bf16x8*)(H + (size_t)(r0 + i) * D + 32 * ks + 8 * gq);
                const bf16x8 b0 = *(const bf16x8*)(Wdt_t + (size_t)i * D + 32 * ks + 8 * gq), b1 = *(const bf16x8*)(Wdt_t + (size_t)(16 + i) * D + 32 * ks + 8 * gq);
                a0 = MFMA16(af, b0, a0); a1 = MFMA16(af, b1, a1);
            }
#pragma unroll
            for (int r = 0; r < 4; ++r) { DT[(size_t)(r0 + 4 * gq + r) * NH + i] = a0[r]; DT[(size_t)(r0 + 4 * gq + r) * NH + 16 + i] = a1[r]; }
        }
    }
#if DUP_PH == 102
    xcd_barrier(xbar);
    {
        PHASE_IDS
        pg8::Gemm g{H, Win_t, T, 6144, D}; pg8::StaticOrder S; S.init(T, 6144, G, (int)blockIdx.x);
        pg8::EpiMk<0> E{}; E.O0 = Z; E.O1 = XBC; E.O2 = UPOOL; E.halo = HALO; E.ldc = 0;
        pg8::gemm_phase<pg8::EpiMk<0>, pg8::StaticOrder, true, true>(gl, g, S, E);
        const int gq = lane >> 4, i = lane & 15;
        REP(21)
        for (int it = gw; it < T / 16; it += NGW) {
            const int r0 = it * 16; f32x4 a0 = {0.f, 0.f, 0.f, 0.f}, a1 = {0.f, 0.f, 0.f, 0.f};
#pragma unroll 4
            for (int ks = 0; ks < 32; ++ks) {
                const bf16x8 af = *(const bf16x8*)(H + (size_t)(r0 + i) * D + 32 * ks + 8 * gq);
                const bf16x8 b0 = *(const bf16x8*)(Wdt_t + (size_t)i * D + 32 * ks + 8 * gq), b1 = *(const bf16x8*)(Wdt_t + (size_t)(16 + i) * D + 32 * ks + 8 * gq);
                a0 = MFMA16(af, b0, a0); a1 = MFMA16(af, b1, a1);
            }
#pragma unroll
            for (int r = 0; r < 4; ++r) { DT[(size_t)(r0 + 4 * gq + r) * NH + i] = a0[r]; DT[(size_t)(r0 + 4 * gq + r) * NH + 16 + i] = a1[r]; }
        }
    }
#endif
    xcd_barrier(xbar);
    STAMP(3);
    {
        PHASE_IDS
        const int tx = tid & 63, ty = tid >> 6;
        REP(30)
        for (int it = blockIdx.x; it < 768; it += G) {
            const int ch = it / 6, cb = it % 6; const int ch0 = cb * 512 + tx * 8; const size_t row0 = (size_t)ch * 128 + ty * 16;
            v4u raw[19];
#pragma unroll
            for (int r = 0; r < 16; ++r) raw[3 + r] = *(const v4u*)(XBC + (row0 + r) * XW + ch0);
            if (ty > 0) {
#pragma unroll
                for (int r = 0; r < 3; ++r) raw[r] = *(const v4u*)(XBC + (row0 - 3 + r) * XW + ch0);
            } else if ((ch & 63) != 0) {
#pragma unroll
                for (int r = 0; r < 3; ++r) raw[r] = *(const v4u*)(HALO + ((size_t)(ch - 1) * 3 + r) * XW + ch0);
            } else {
#pragma unroll
                for (int r = 0; r < 3; ++r) raw[r] = (v4u){0u, 0u, 0u, 0u};
            }
            asm volatile("s_waitcnt vmcnt(0)" ::: "memory"); __syncthreads();
            float wv[4][8], bv[8];
#pragma unroll
            for (int k = 0; k < 4; ++k) { const f32x4 a = *(const f32x4*)(conv_w + (size_t)k * XW + ch0), b = *(const f32x4*)(conv_w + (size_t)k * XW + ch0 + 4);
                wv[k][0] = a.x; wv[k][1] = a.y; wv[k][2] = a.z; wv[k][3] = a.w; wv[k][4] = b.x; wv[k][5] = b.y; wv[k][6] = b.z; wv[k][7] = b.w; }
            { const f32x4 a = *(const f32x4*)(conv_b + ch0), b = *(const f32x4*)(conv_b + ch0 + 4); bv[0] = a.x; bv[1] = a.y; bv[2] = a.z; bv[3] = a.w; bv[4] = b.x; bv[5] = b.y; bv[6] = b.z; bv[7] = b.w; }
#pragma unroll
            for (int r = 0; r < 16; ++r) {
                v4u o;
#pragma unroll
                for (int e = 0; e < 4; ++e) {
                    float lo = bv[2 * e], hi = bv[2 * e + 1];
#pragma unroll
                    for (int k = 0; k < 4; ++k) { const unsigned u = raw[r + k][e]; lo += wv[k][2 * e] * bflo(u); hi += wv[k][2 * e + 1] * bfhi(u); }
                    o[e] = pk2(siluf(lo), siluf(hi));
                }
                *(v4u*)((DRY(30) ? STATES + 16777216 + (((row0 + r) * XW) & 0x7FFFFF) : XBC + (row0 + r) * XW) + ch0) = o;
            }
        }
        REP(31)
        for (int e = blockIdx.x * 512 + tid; e < 1024 * 128; e += G * 512) {
            const int c8 = (e & 127) * 8, t0 = (e >> 7) * 16, gi = c8 >> 8, win = 2 << gi, pos0 = t0 & (SEQ - 1);
            const bf16* up = UPOOL + (size_t)t0 * D + c8;
            float s[8];
#pragma unroll
            for (int q = 0; q < 8; ++q) s[q] = 0.f;
#pragma unroll
            for (int j = 1; j < 16; ++j) if (j < win && pos0 - j >= 0) { const v4u v = *(const v4u*)(up - (size_t)j * D);
#pragma unroll
                for (int q = 0; q < 4; ++q) { s[2 * q] += bflo(v[q]); s[2 * q + 1] += bfhi(v[q]); } }
#pragma unroll 4
            for (int r = 0; r < 16; ++r) {
                const v4u v = *(const v4u*)(up + (size_t)r * D); const int pos = pos0 + r; const int cnt = (pos + 1 < win) ? pos + 1 : win; const float inv = 1.f / (float)cnt;
                v4u o;
#pragma unroll
                for (int q = 0; q < 4; ++q) { const float lo = bflo(v[q]), hi = bfhi(v[q]); s[2 * q] += lo; s[2 * q + 1] += hi; o[q] = pk2(s[2 * q] * inv - lo, s[2 * q + 1] * inv - hi); }
                *(v4u*)(POOLED + (size_t)(t0 + r) * D + c8) = o;
                if (pos - win + 1 >= 0) { const v4u w = *(const v4u*)(up + (size_t)(r - win + 1) * D);
#pragma unroll
                    for (int q = 0; q < 4; ++q) { s[2 * q] -= bflo(w[q]); s[2 * q + 1] -= bfhi(w[q]); } }
            }
        }
        for (int it = gw; it < 128 * NH; it += NGW) {
            const int ch = it >> 5, h = it & 31; const size_t r0 = (size_t)ch * 128 + 2 * lane; const float bias = dt_bias[h], A = -__expf(a_log[h]);
            float v0 = DT[r0 * NH + h] + bias, v1 = DT[(r0 + 1) * NH + h] + bias;
            const float d0 = v0 > 20.f ? v0 : log1pf(__expf(v0)), d1 = v1 > 20.f ? v1 : log1pf(__expf(v1));
            const float a0 = d0 * A, a1 = d1 * A; float incl = a0 + a1;
#pragma unroll
            for (int o = 1; o < 64; o <<= 1) { const float n = __shfl_up(incl, o); if (lane >= o) incl += n; }
            const float excl = incl - (a0 + a1);
            DT[r0 * NH + h] = d0; DT[(r0 + 1) * NH + h] = d1; ACS[r0 * NH + h] = excl + a0; ACS[(r0 + 1) * NH + h] = excl + a0 + a1;
        }
    }
    xcd_barrier(xbar);
    STAMP(4);
    REP(35)
    {
        pg8::Gemm g{POOLED, Wpp_t, T, D, D}; pg8::StaticOrder S; S.init(T, D, G, (int)blockIdx.x);
        pg8::EpiMk<2> E{}; E.O0 = YPOOL; E.ldc = D;
        pg8::gemm_phase<pg8::EpiMk<2>, pg8::StaticOrder, true, true>(gl, g, S, E);
    }

#if DUP_PH == 135
    xcd_barrier(xbar);
    {
        pg8::Gemm g{POOLED, Wpp_t, T, D, D}; pg8::StaticOrder S; S.init(T, D, G, (int)blockIdx.x);
        pg8::EpiMk<2> E{}; E.O0 = YPOOL; E.ldc = D;
        pg8::gemm_phase<pg8::EpiMk<2>, pg8::StaticOrder, true, true>(gl, g, S, E);
    }

#endif
    xcd_barrier(xbar);
    STAMP(5);
    REP(4)
    {
        PHASE_IDS
        const int gq = lane >> 4, li = lane & 15, lr = li >> 2, lc = li & 3;
        unsigned char* ldsB = lds; unsigned char* ldsX = lds + 34816;
        for (int it = blockIdx.x; it < 512; it += G) {
            const int bc = it >> 2, g = it & 3; const size_t row0 = (size_t)bc * 128;
            for (int q = tid; q < 2048; q += 512) { const int r = q >> 4, c16 = q & 15; *(v4u*)(ldsB + r * 272 + c16 * 16) = *(const v4u*)(XBC + (row0 + r) * XW + 2048 + g * 128 + c16 * 8); }
            __syncthreads();
            bf16x8 Af[4];
#pragma unroll
            for (int ks = 0; ks < 4; ++ks) Af[ks] = cat8(ds_tr(ldsB + (32 * ks + 8 * gq + lr) * 272 + (16 * wave + 4 * lc) * 2), ds_tr(ldsB + (32 * ks + 8 * gq + 4 + lr) * 272 + (16 * wave + 4 * lc) * 2));
#pragma unroll 1
            for (int hh = 0; hh < 8; ++hh) {
                const int h = 8 * g + hh;
                { const int r = tid >> 2, qc = tid & 3;
                  const float sc = DT[(row0 + r) * NH + h] * __expf(ACS[(row0 + 127) * NH + h] - ACS[(row0 + r) * NH + h]);
#pragma unroll
                  for (int e = 0; e < 2; ++e) { const v4u v = *(const v4u*)(XBC + (row0 + r) * XW + h * 64 + qc * 16 + e * 8); v4u o;
#pragma unroll
                      for (int q = 0; q < 4; ++q) o[q] = pk2(bflo(v[q]) * sc, bfhi(v[q]) * sc);
                      *(v4u*)(ldsX + r * 144 + (qc * 16 + e * 8) * 2) = o; } }
                __syncthreads();
                f32x4 acc[4];
#pragma unroll
                for (int pt = 0; pt < 4; ++pt) acc[pt] = (f32x4){0.f, 0.f, 0.f, 0.f};
#pragma unroll
                for (int ks = 0; ks < 4; ++ks)
#pragma unroll
                    for (int pt = 0; pt < 4; ++pt) {
                        const bf16x8 bx = cat8(ds_tr(ldsX + (32 * ks + 8 * gq + lr) * 144 + (16 * pt + 4 * lc) * 2), ds_tr(ldsX + (32 * ks + 8 * gq + 4 + lr) * 144 + (16 * pt + 4 * lc) * 2));
                        acc[pt] = MFMA16(Af[ks], bx, acc[pt]);
                    }
                bf16* st = STATES + ((size_t)bc * NH + h) * 8192;
#pragma unroll
                for (int pt = 0; pt < 4; ++pt) { v2u o; o.x = pk2(acc[pt][0], acc[pt][1]); o.y = pk2(acc[pt][2], acc[pt][3]); *(v2u*)(st + (16 * pt + li) * 128 + 16 * wave + 4 * gq) = o; }
                __syncthreads();
            }
        }
    }
    xcd_barrier(xbar);
    STAMP(6);
    REP(5)
    { PHASE_IDS
    for (int e = blockIdx.x * 512 + tid; e < 131072; e += G * 512) {
        const int n4 = e & 31, p = (e >> 5) & 63, h = (e >> 11) & 31, b = e >> 16;
        float s0 = 0.f, s1 = 0.f, s2 = 0.f, s3 = 0.f;
#pragma unroll 8
        for (int c = 0; c < 64; ++c) {
            v2u* ptr = (v2u*)(STATES + (((size_t)(b * 64 + c) * NH + h) * 64 + p) * 128 + n4 * 4);
            const v2u v = *ptr; const float d = __expf(ACS[((size_t)b * SEQ + c * 128 + 127) * NH + h]);
            v2u o; o.x = pk2(s0, s1); o.y = pk2(s2, s3); *(DRY(5) ? (v2u*)(HALO) + (((size_t)c * 131072 + e) & 0x3FFFF) : ptr) = o;
            s0 = s0 * d + bflo(v.x); s1 = s1 * d + bfhi(v.x); s2 = s2 * d + bflo(v.y); s3 = s3 * d + bfhi(v.y);
        }
    } }

    xcd_barrier(xbar);
    STAMP(7);
    REP(6)
    {
        PHASE_IDS
        const int gq = lane >> 4, li = lane & 15, lr = li >> 2, lc = li & 3;
        unsigned char* ldsX = lds; unsigned char* ldsP = lds + 69632; float* ldsA = (float*)(lds + 135168); float* ldsD = (float*)(lds + 139264);
        unsigned char* stg = lds + 143360 + wave * 2304; const int rl = lane >> 2, cc = lane & 3;
        for (int it = blockIdx.x; it < 512; it += G) {
            const int bc = it >> 2, g = it & 3; const size_t row0 = (size_t)bc * 128;
            bf16x8 Cf[4];
            { const bf16* Cg = XBC + (row0 + 16 * wave + li) * XW + 2560 + g * 128 + 8 * gq;
#pragma unroll
              for (int ks = 0; ks < 4; ++ks) Cf[ks] = *(const bf16x8*)(Cg + 32 * ks); }
            f32x4 sc[8];
#pragma unroll
            for (int st = 0; st < 8; ++st) { sc[st] = (f32x4){0.f, 0.f, 0.f, 0.f};
                if (st <= wave) { const bf16* Bg = XBC + (row0 + 16 * st + li) * XW + 2048 + g * 128 + 8 * gq;
#pragma unroll
                    for (int ks = 0; ks < 4; ++ks) { const bf16x8 af = *(const bf16x8*)(Bg + 32 * ks); sc[st] = MFMA16(af, Cf[ks], sc[st]); }
                } }
            const int lrow = 16 * wave + li;
            float ssq = 0.f;
            bool dmask[4];
#pragma unroll
            for (int r = 0; r < 4; ++r) dmask[r] = (4 * gq + r <= li);
#pragma unroll 1
            for (int hf = 0; hf < 2; ++hf) {
            __syncthreads();
            for (int q = tid; q < 4096; q += 512) { const int r = q >> 5, c16 = q & 31; *(v4u*)(ldsX + r * 544 + c16 * 16) = *(const v4u*)(XBC + (row0 + r) * XW + g * 512 + hf * 256 + c16 * 8); }
            for (int q = tid; q < 4096; q += 512) { const int hq = q >> 10, p = (q >> 4) & 63, c = q & 15;
                *(v4u*)(ldsP + hq * 16384 + p * 256 + ((c ^ (p & 15)) * 16)) = *(const v4u*)(STATES + ((size_t)bc * NH + 8 * g + 4 * hf + hq) * 8192 + p * 128 + c * 8); }
            if (hf == 0) for (int q = tid; q < 1024; q += 512) { const int hh = q >> 7, r = q & 127; ldsA[q] = ACS[(row0 + r) * NH + 8 * g + hh]; ldsD[q] = DT[(row0 + r) * NH + 8 * g + hh]; }
            __syncthreads();
#pragma unroll 1
            for (int hq = 0; hq < 4; ++hq) {
                const int hh = 4 * hf + hq, h = 8 * g + hh; const unsigned char* xh = ldsX + hq * 128; const unsigned char* ph = ldsP + hq * 16384;
                const float* aA = ldsA + hh * 128; const float* aD = ldsD + hh * 128;
                v4u* zp0 = (v4u*)(Z + (row0 + 16 * wave + rl) * DI + h * 64 + cc * 16);
                const v4u zv0 = zp0[0], zv1 = zp0[1];
                const float al = aA[lrow];
                f32x4 acc[4], acc2[4];
#pragma unroll
                for (int pt = 0; pt < 4; ++pt) { acc[pt] = (f32x4){0.f, 0.f, 0.f, 0.f}; acc2[pt] = (f32x4){0.f, 0.f, 0.f, 0.f}; }
#pragma unroll
                for (int q = 0; q < 4; ++q) {
                    if (2 * q <= wave) {
                        const f32x4 as0 = *(const f32x4*)(aA + 32 * q + 4 * gq), as1 = *(const f32x4*)(aA + 32 * q + 16 + 4 * gq);
                        const f32x4 dd0 = *(const f32x4*)(aD + 32 * q + 4 * gq), dd1 = *(const f32x4*)(aD + 32 * q + 16 + 4 * gq);
                        float mv[8];
#pragma unroll
                        for (int r = 0; r < 4; ++r) {
                            float v0 = sc[2 * q][r] * (__expf(fminf(al - as0[r], 0.f)) * dd0[r]);
                            float v1 = sc[2 * q + 1][r] * (__expf(fminf(al - as1[r], 0.f)) * dd1[r]);
                            if (2 * q == wave && !dmask[r]) v0 = 0.f;
                            if (2 * q + 1 == wave && !dmask[r]) v1 = 0.f;
                            mv[r] = v0; mv[4 + r] = v1;
                        }
                        v4u mp; mp.x = pk2(mv[0], mv[1]); mp.y = pk2(mv[2], mv[3]); mp.z = pk2(mv[4], mv[5]); mp.w = pk2(mv[6], mv[7]);
                        const bf16x8 Mf = __builtin_bit_cast(bf16x8, mp);
#pragma unroll
                        for (int pt = 0; pt < 4; ++pt) {
                            const bf16x8 ax = cat8(ds_tr(xh + (32 * q + 4 * gq + lr) * 544 + (16 * pt + 4 * lc) * 2), ds_tr(xh + (32 * q + 16 + 4 * gq + lr) * 544 + (16 * pt + 4 * lc) * 2));
                            acc[pt] = MFMA16(ax, Mf, acc[pt]);
                        }
                    }
                }
#pragma unroll
                for (int pt = 0; pt < 4; ++pt)
#pragma unroll
                    for (int ks = 0; ks < 4; ++ks) { const bf16x8 ap = *(const bf16x8*)(ph + (16 * pt + li) * 256 + (((4 * ks + gq) ^ li) * 16)); acc2[pt] = MFMA16(ap, Cf[ks], acc2[pt]); }
                const float el = __expf(al), Dh = d_skip[h];
#pragma unroll
                for (int pt = 0; pt < 4; ++pt) { const f32x4 yy = acc[pt] + acc2[pt] * el; v2u o; o.x = pk2(yy[0], yy[1]); o.y = pk2(yy[2], yy[3]); *(v2u*)(stg + li * 144 + (16 * pt + 4 * gq) * 2) = o; }
                const v4u ys0 = *(const v4u*)(stg + rl * 144 + cc * 32), ys1 = *(const v4u*)(stg + rl * 144 + cc * 32 + 16);
                const v4u xs0 = *(const v4u*)(xh + (16 * wave + rl) * 544 + cc * 32), xs1 = *(const v4u*)(xh + (16 * wave + rl) * 544 + cc * 32 + 16);
                v4u o0, o1;
#pragma unroll
                for (int q = 0; q < 4; ++q) {
                    const float a0 = (bflo(ys0[q]) + Dh * bflo(xs0[q])) * siluf(bflo(zv0[q])), a1 = (bfhi(ys0[q]) + Dh * bfhi(xs0[q])) * siluf(bfhi(zv0[q]));
                    const float b0 = (bflo(ys1[q]) + Dh * bflo(xs1[q])) * siluf(bflo(zv1[q])), b1 = (bfhi(ys1[q]) + Dh * bfhi(xs1[q])) * siluf(bfhi(zv1[q]));
                    ssq += (a0 * a0 + a1 * a1) + (b0 * b0 + b1 * b1);
                    o0[q] = pk2(a0, a1); o1[q] = pk2(b0, b1);
                }
                v4u* zq = zp0; if (DRY(6)) zq = (v4u*)(HALO + ((((row0 + 16 * wave + rl) * DI + h * 64 + cc * 16)) & 0xFFFF0));
                zq[0] = o0; zq[1] = o1;
            }
            }
            ssq += __shfl_xor(ssq, 1); ssq += __shfl_xor(ssq, 2);
            const float rstd = rsqrtf(ssq * (1.f / 512.f) + EPS);
#pragma unroll 2
            for (int hh = 0; hh < 8; ++hh) {
                const int chn = 512 * g + 64 * hh + 16 * cc;
                v4u* zq = (v4u*)(Z + (row0 + 16 * wave + rl) * DI + chn); if (DRY(6)) zq = (v4u*)(HALO + ((((row0 + 16 * wave + rl) * DI + chn)) & 0xFFFF0));
                const v4u y0 = zq[0], y1 = zq[1];
                const f32x4 n0 = *(const f32x4*)(ssd_norm_w + chn), n1 = *(const f32x4*)(ssd_norm_w + chn + 4), n2 = *(const f32x4*)(ssd_norm_w + chn + 8), n3 = *(const f32x4*)(ssd_norm_w + chn + 12);
                v4u o0, o1;
                o0[0] = pk2(bflo(y0[0]) * rstd * n0[0], bfhi(y0[0]) * rstd * n0[1]); o0[1] = pk2(bflo(y0[1]) * rstd * n0[2], bfhi(y0[1]) * rstd * n0[3]);
                o0[2] = pk2(bflo(y0[2]) * rstd * n1[0], bfhi(y0[2]) * rstd * n1[1]); o0[3] = pk2(bflo(y0[3]) * rstd * n1[2], bfhi(y0[3]) * rstd * n1[3]);
                o1[0] = pk2(bflo(y1[0]) * rstd * n2[0], bfhi(y1[0]) * rstd * n2[1]); o1[1] = pk2(bflo(y1[1]) * rstd * n2[2], bfhi(y1[1]) * rstd * n2[3]);
                o1[2] = pk2(bflo(y1[2]) * rstd * n3[0], bfhi(y1[2]) * rstd * n3[1]); o1[3] = pk2(bflo(y1[3]) * rstd * n3[2], bfhi(y1[3]) * rstd * n3[3]);
                zq[0] = o0; zq[1] = o1;
            }
            __syncthreads();
        }
    }
    xcd_barrier(xbar);
    STAMP(8);
    REP(70)
    {
        PHASE_IDS
        pg8::Gemm g{H, Win_t + (size_t)6144 * D, T, 2048, D}; pg8::StaticOrder S; S.init(T, 2048, G, (int)blockIdx.x);
        pg8::EpiMk<1> E{}; E.O0 = GATES; E.ldc = 2048;
        pg8::gemm_phase<pg8::EpiMk<1>, pg8::StaticOrder, true, true>(gl, g, S, E);
        LAS float* scr = (LAS float*)(gl + wave * 16384);
        REP(72)
        for (int it = gw; it < 4096; it += NGW) {
            if (it < 2048) transpose_item(w_up, FF, (it / 128) * 64, (it % 128) * 32, Wup_t, D, (it % 128) * 32, scr, lane);
            else { const int r = it - 2048; transpose_item(w_down, D, (r / 32) * 64, (r % 32) * 32, Wdown_t, FF, (r % 32) * 32, scr, lane); }
        }
    }
#if DUP_PH == 170
    xcd_barrier(xbar);
    {
        PHASE_IDS
        pg8::Gemm g{H, Win_t + (size_t)6144 * D, T, 2048, D}; pg8::StaticOrder S; S.init(T, 2048, G, (int)blockIdx.x);
        pg8::EpiMk<1> E{}; E.O0 = GATES; E.ldc = 2048;
        pg8::gemm_phase<pg8::EpiMk<1>, pg8::StaticOrder, true, true>(gl, g, S, E);
        LAS float* scr = (LAS float*)(gl + wave * 16384);
        REP(72)
        for (int it = gw; it < 4096; it += NGW) {
            if (it < 2048) transpose_item(w_up, FF, (it / 128) * 64, (it % 128) * 32, Wup_t, D, (it % 128) * 32, scr, lane);
            else { const int r = it - 2048; transpose_item(w_down, D, (r / 32) * 64, (r % 32) * 32, Wdown_t, FF, (r % 32) * 32, scr, lane); }
        }
    }
#endif
    xcd_barrier(xbar);
    STAMP(9);
    REP(71)
    {
        pg8::Gemm g{Z, Wbssd_t, T, D, DI}; pg8::StaticOrder S; S.init(T, D, G, (int)blockIdx.x);
        pg8::EpiMk<3> E{}; E.O0 = MERGED; E.ldc = D; E.G = GATES; E.YP = YPOOL;
        pg8::gemm_phase<pg8::EpiMk<3>, pg8::StaticOrder, true, true>(gl, g, S, E);
    }
#if DUP_PH == 171
    xcd_barrier(xbar);
    {
        pg8::Gemm g{Z, Wbssd_t, T, D, DI}; pg8::StaticOrder S; S.init(T, D, G, (int)blockIdx.x);
        pg8::EpiMk<3> E{}; E.O0 = MERGED; E.ldc = D; E.G = GATES; E.YP = YPOOL;
        pg8::gemm_phase<pg8::EpiMk<3>, pg8::StaticOrder, true, true>(gl, g, S, E);
    }
#endif
    xcd_barrier(xbar);
    STAMP(10);
    REP(8)
    {
        pg8::Gemm g{MERGED, Wout_t, T, D, D}; pg8::StaticOrder S; S.init(T, D, G, (int)blockIdx.x);
        pg8::EpiMk<4> E{}; E.ldc = D; E.X0 = x; E.OF = X1; E.gate = MOD + 2048;
        pg8::gemm_phase<pg8::EpiMk<4>, pg8::StaticOrder, true, true>(gl, g, S, E);
    }
#if DUP_PH == 108
    xcd_barrier(xbar);
    {
        pg8::Gemm g{MERGED, Wout_t, T, D, D}; pg8::StaticOrder S; S.init(T, D, G, (int)blockIdx.x);
        pg8::EpiMk<4> E{}; E.ldc = D; E.X0 = x; E.OF = X1; E.gate = MOD + 2048;
        pg8::gemm_phase<pg8::EpiMk<4>, pg8::StaticOrder, true, true>(gl, g, S, E);
    }
#endif
    xcd_barrier(xbar);
    STAMP(11);
    REP(9)
    { PHASE_IDS
    for (int m = gw; m < T; m += NGW) { const float* md = MOD + (m >> 13) * NMOD; norm_mod_row(X1 + (size_t)m * D, norm_mlp_w, md + 4096, md + 3072, H2 + (size_t)m * D, lane); } }
    xcd_barrier(xbar);
    STAMP(12);
    REP(10)
    {
        pg8::Gemm g{H2, Wup_t, T, FF, D}; pg8::StaticOrder S; S.init(T, FF, G, (int)blockIdx.x);
        pg8::EpiMk<5> E{}; E.O0 = UPB; E.ldc = FF;
        pg8::gemm_phase<pg8::EpiMk<5>, pg8::StaticOrder, true, true>(gl, g, S, E);
    }
#if DUP_PH == 110
    xcd_barrier(xbar);
    {
        pg8::Gemm g{H2, Wup_t, T, FF, D}; pg8::StaticOrder S; S.init(T, FF, G, (int)blockIdx.x);
        pg8::EpiMk<5> E{}; E.O0 = UPB; E.ldc = FF;
        pg8::gemm_phase<pg8::EpiMk<5>, pg8::StaticOrder, true, true>(gl, g, S, E);
    }
#endif
    xcd_barrier(xbar);
    STAMP(13);
    {
        pg8::Gemm g{UPB, Wdown_t, T, D, FF}; pg8::StaticOrder S; S.init(T, D, G, (int)blockIdx.x);
        pg8::EpiMk<4> E{}; E.ldc = D; E.X0 = X1; E.OF = X1; E.gate = MOD + 5120;
        pg8::gemm_phase<pg8::EpiMk<4>, pg8::StaticOrder, true, true>(gl, g, S, E);
    }
    xcd_barrier(xbar);
    STAMP(14);
    { PHASE_IDS
    for (int m = gw; m < T; m += NGW) {
        f32x4* xr = (f32x4*)(X1 + (size_t)m * D) + lane; f32x4 v[4]; float s = 0.f;
#pragma unroll
        for (int j = 0; j < 4; ++j) { v[j] = xr[64 * j]; s += (v[j].x * v[j].x + v[j].y * v[j].y) + (v[j].z * v[j].z + v[j].w * v[j].w); }
        const float rstd = rsqrtf(wave_sum(s) * (1.f / D) + EPS);
#pragma unroll
        for (int j = 0; j < 4; ++j) xr[64 * j] = v[j] * rstd * ((const f32x4*)norm_final_w)[lane + 64 * j];
    } }
#ifdef TPROBE
    xcd_barrier(xbar);
    STAMP(15);
    if (blockIdx.x == 0) {
        PHASE_IDS
        __syncthreads();
        const float A = (float)(TS[TA_HI] - TS[TA_LO]) * 0.01f, B = (float)(TS[TB_HI] - TS[TB_LO]) * 0.01f;
        if (tid == 0) P.out[0] += A;
        for (int k = 1 + tid; k <= 10000; k += 512) P.out[(size_t)k * 1024] += B;
    }
#endif
}

extern "C" void kernel_launch(void* const* d_in, const int* in_sizes, int n_in, void* d_out, int out_size, void* d_ws, size_t ws_size, hipStream_t stream) {
    static int grid_blocks = 0;
    if (!grid_blocks) {
        int dev = 0, cus = 0, per_cu = 0;
        hipGetDevice(&dev);
        hipDeviceGetAttribute(&cus, hipDeviceAttributeMultiprocessorCount, dev);
        hipFuncSetAttribute((const void*)mk_fwd, hipFuncAttributeMaxDynamicSharedMemorySize, LDS_BYTES);
        hipOccupancyMaxActiveBlocksPerMultiprocessor(&per_cu, (const void*)mk_fwd, 512, LDS_BYTES);
        if (per_cu < 1) { fprintf(stderr, "occupancy query reports %d blocks/CU\n", per_cu); per_cu = 1; }
        grid_blocks = cus * 1;
        if (n_in != 21 || ws_size < 256 * MiB) fprintf(stderr, "kernel_launch: unexpected n_in %d / ws_size %zu\n", n_in, ws_size);
    }
    (void)hipMemsetAsync((char*)d_ws + WS_BAR, 0, 16384, stream);
    Params p{};
    for (int i = 0; i < 21; ++i) p.in[i] = (const float*)d_in[i];
    p.out = (float*)d_out; p.ws = (unsigned char*)d_ws;
    void* args[] = {&p};
    hipError_t e = hipLaunchCooperativeKernel((const void*)mk_fwd, dim3(grid_blocks), dim3(512), args, LDS_BYTES, stream);
    if (e != hipSuccess) fprintf(stderr, "cooperative launch failed: %s (grid %d)\n", hipGetErrorString(e), grid_blocks);
}
```
